# Optimizing an MI355X kernel written in HIP

```python
import jax, jax.numpy as jnp
from jax import lax
import numpy as np

D_MODEL = 1024
BATCH = 8
SEQ = 4096
DEPTH = 1

CHUNK = 64
Q_BLOCK = 128
MLA_HEADS = 8
MLA_NOPE = 64
MLA_ROPE = 32
MLA_QK = MLA_NOPE + MLA_ROPE
MLA_V = 64
Q_LORA = 256
KV_LORA = 128
ROPE_BASE = 10000.0
CA_HEADS = 8
CA_HEAD_DIM = 64
LEFT_CHUNKS = 8
BAND = (LEFT_CHUNKS + 1) * CHUNK
MAX_REL = 256
MLA_WIDTH = MLA_HEADS * MLA_V
CA_WIDTH = CA_HEADS * CA_HEAD_DIM
IN_WIDTHS = (Q_LORA, KV_LORA, MLA_ROPE, CA_WIDTH, CA_WIDTH, CA_WIDTH, D_MODEL, D_MODEL)
IN_WIDTH = Q_LORA + KV_LORA + MLA_ROPE + 3 * CA_WIDTH + 2 * D_MODEL
N_GROUPS = 4
EXPERTS_PER_GROUP = 8
N_EXPERTS = N_GROUPS * EXPERTS_PER_GROUP
TOP_K = 2
EXPERT_FF = 256
NORM_EPS = 1e-6
NEG_INF = -1e30
N_MOD = 6

kernel_name = 'hybrid_mla_chunkattn_hmoe_adaln'


def rms_norm(x, g):
    xf = x.astype(jnp.float32)
    y = xf * lax.rsqrt(jnp.mean(xf * xf, axis=-1, keepdims=True) + NORM_EPS)
    return (y * g.astype(jnp.float32)).astype(x.dtype)


def modulate(x, shift, scale):
    return x * (1 + scale[:, None, :]) + shift[:, None, :]


def rope(x, positions):
    half = x.shape[-1] // 2
    inv = ROPE_BASE ** (-jnp.arange(half, dtype=jnp.float32) / half)
    ang = positions.astype(jnp.float32)[..., None] * inv
    ang = ang.reshape(ang.shape[:2] + (1,) * (x.ndim - 3) + (half,))
    cos = jnp.cos(ang).astype(x.dtype)
    sin = jnp.sin(ang).astype(x.dtype)
    x1, x2 = x[..., :half], x[..., half:]
    return jnp.concatenate([x1 * cos - x2 * sin, x2 * cos + x1 * sin], axis=-1)


def mla_attend(q, k, v):
    b, s, h, _ = q.shape
    n_blocks = s // Q_BLOCK
    scale = MLA_QK ** -0.5
    key_chunk = jnp.arange(s) // CHUNK

    def one_block(i):
        qb = lax.dynamic_slice_in_dim(q, i * Q_BLOCK, Q_BLOCK, axis=1)
        sc = jnp.einsum('bqhd,bkhd->bhqk', qb, k).astype(jnp.float32) * scale
        q_chunk = (i * Q_BLOCK + jnp.arange(Q_BLOCK)) // CHUNK
        mask = key_chunk[None, :] <= q_chunk[:, None]
        sc = jnp.where(mask[None, None], sc, NEG_INF)
        p = jax.nn.softmax(sc, axis=-1).astype(v.dtype)
        return jnp.einsum('bhqk,bkhd->bqhd', p, v)

    out = lax.map(one_block, jnp.arange(n_blocks))
    return out.transpose(1, 0, 2, 3, 4).reshape(b, s, h * v.shape[-1])


def chunk_band_attend(q, k, v, rel_table):
    b, s, h, d = q.shape
    n_chunks = s // CHUNK
    scale = d ** -0.5
    pad = ((0, 0), (LEFT_CHUNKS * CHUNK, 0), (0, 0), (0, 0))
    kp = jnp.pad(k, pad)
    vp = jnp.pad(v, pad)
    rel = (jnp.arange(CHUNK)[:, None] + LEFT_CHUNKS * CHUNK) - jnp.arange(BAND)[None, :]
    idx = jnp.clip(rel, -MAX_REL, MAX_REL) + MAX_REL
    bias = rel_table.astype(jnp.float32)[:, idx]

    def one_chunk(n):
        qc = lax.dynamic_slice_in_dim(q, n * CHUNK, CHUNK, axis=1)
        kb = lax.dynamic_slice_in_dim(kp, n * CHUNK, BAND, axis=1)
        vb = lax.dynamic_slice_in_dim(vp, n * CHUNK, BAND, axis=1)
        sc = jnp.einsum('bqhd,bkhd->bhqk', qc, kb).astype(jnp.float32) * scale + bias[None]
        valid = (n * CHUNK - LEFT_CHUNKS * CHUNK + jnp.arange(BAND)) >= 0
        sc = jnp.where(valid[None, None, None, :], sc, NEG_INF)
        p = jax.nn.softmax(sc, axis=-1).astype(vb.dtype)
        return jnp.einsum('bhqk,bkhd->bqhd', p, vb)

    out = lax.map(one_chunk, jnp.arange(n_chunks))
    return out.transpose(1, 0, 2, 3, 4).reshape(b, s, h * d)


def hybrid_mixer(h, positions, w_in, g_q, w_uq, g_kv, w_uk, w_uv, rel_table, w_oa, w_ob, w_out):
    b, s, _ = h.shape
    proj = h @ w_in
    cuts = [int(v) for v in np.cumsum(IN_WIDTHS)[:-1]]
    q_lat, kv_lat, k_rope, q_b, k_b, v_b, gate_a, gate_b = jnp.split(proj, cuts, axis=-1)
    q_a = (rms_norm(q_lat, g_q) @ w_uq).reshape(b, s, MLA_HEADS, MLA_QK)
    q_a = jnp.concatenate([q_a[..., :MLA_NOPE], rope(q_a[..., MLA_NOPE:], positions)], axis=-1)
    kv_n = rms_norm(kv_lat, g_kv)
    k_nope = (kv_n @ w_uk).reshape(b, s, MLA_HEADS, MLA_NOPE)
    v_a = (kv_n @ w_uv).reshape(b, s, MLA_HEADS, MLA_V)
    k_r = rope(k_rope, positions)
    k_a = jnp.concatenate(
        [k_nope, jnp.broadcast_to(k_r[:, :, None, :], (b, s, MLA_HEADS, MLA_ROPE))], axis=-1)
    o_a = mla_attend(q_a, k_a, v_a)
    o_b = chunk_band_attend(
        q_b.reshape(b, s, CA_HEADS, CA_HEAD_DIM),
        k_b.reshape(b, s, CA_HEADS, CA_HEAD_DIM),
        v_b.reshape(b, s, CA_HEADS, CA_HEAD_DIM), rel_table)
    merged = jax.nn.sigmoid(gate_a) * (o_a @ w_oa) + jax.nn.sigmoid(gate_b) * (o_b @ w_ob)
    return merged @ w_out


def hierarchical_moe(h, w_rg, b_rg, w_re, b_re, w_gate, w_up, w_down):
    b, s, d = h.shape
    t = h.reshape(b * s, d)
    n_tok = t.shape[0]
    g_prob = jax.nn.softmax((t @ w_rg + b_rg).astype(jnp.float32), axis=-1)
    g_w, g_idx = lax.top_k(g_prob, 1)
    g_w, g_idx = g_w[:, 0], g_idx[:, 0]
    e_logits = (t @ w_re + b_re).astype(jnp.float32).reshape(n_tok, N_GROUPS, EXPERTS_PER_GROUP)
    e_sel = jnp.take_along_axis(e_logits, g_idx[:, None, None], axis=1)[:, 0]
    e_prob = jax.nn.softmax(e_sel, axis=-1)
    top_w, top_i = lax.top_k(e_prob, TOP_K)
    top_w = top_w / jnp.sum(top_w, axis=-1, keepdims=True)
    in_group = jnp.sum(jax.nn.one_hot(top_i, EXPERTS_PER_GROUP, dtype=jnp.float32) * top_w[..., None], axis=1)
    combine = (jax.nn.one_hot(g_idx, N_GROUPS, dtype=jnp.float32)[:, :, None]
               * in_group[:, None, :] * g_w[:, None, None]).astype(h.dtype)
    y = jnp.zeros_like(t)
    for g in range(N_GROUPS):
        sl = slice(g * EXPERTS_PER_GROUP, (g + 1) * EXPERTS_PER_GROUP)
        a = jnp.einsum('td,edf->tef', t, w_gate[sl])
        u = jnp.einsum('td,edf->tef', t, w_up[sl])
        hid = jax.nn.silu(a) * u * combine[:, g, :, None]
        y = y + jnp.einsum('tef,efd->td', hid, w_down[sl])
    return y.reshape(b, s, d)


def setup_inputs(seed: int = 0) -> dict:
    key = jax.random.key(seed)
    ks = iter(jax.random.split(key, 32))
    L, D = DEPTH, D_MODEL

    def w(shape, fan_in):
        return jax.random.normal(next(ks), shape, jnp.float32) * (fan_in ** -0.5)

    def gain(shape):
        return 1.0 + 0.02 * jax.random.normal(next(ks), shape, jnp.float32)

    def small(shape, s=0.01):
        return s * jax.random.normal(next(ks), shape, jnp.float32)

    x = jax.random.normal(next(ks), (BATCH, SEQ, D), jnp.float32)
    c = jax.random.normal(next(ks), (BATCH, D), jnp.float32)
    offsets = jax.random.randint(next(ks), (BATCH, 1), 0, 10000, dtype=jnp.int32)
    positions = offsets + jnp.arange(SEQ, dtype=jnp.int32)[None, :]
    return {
        'x': x,
        'c': c,
        'positions': positions,
        'w_ada': w((L, D, N_MOD * D), D),
        'b_ada': small((L, N_MOD * D), 0.02),
        'g_mix': gain((L, D)),
        'w_in': w((L, D, IN_WIDTH), D),
        'g_q': gain((L, Q_LORA)),
        'w_uq': w((L, Q_LORA, MLA_HEADS * MLA_QK), Q_LORA),
        'g_kv': gain((L, KV_LORA)),
        'w_uk': w((L, KV_LORA, MLA_HEADS * MLA_NOPE), KV_LORA),
        'w_uv': w((L, KV_LORA, MLA_WIDTH), KV_LORA),
        'rel_bias': small((L, CA_HEADS, 2 * MAX_REL + 1), 0.5),
        'w_oa': w((L, MLA_WIDTH, D), MLA_WIDTH),
        'w_ob': w((L, CA_WIDTH, D), CA_WIDTH),
        'w_out': w((L, D, D), D),
        'g_ffn': gain((L, D)),
        'w_rg': w((L, D, N_GROUPS), D),
        'b_rg': small((L, N_GROUPS)),
        'w_re': w((L, D, N_EXPERTS), D),
        'b_re': small((L, N_EXPERTS)),
        'w_gate': w((L, N_EXPERTS, D, EXPERT_FF), D),
        'w_up': w((L, N_EXPERTS, D, EXPERT_FF), D),
        'w_down': w((L, N_EXPERTS, EXPERT_FF, D), EXPERT_FF),
        'g_final': gain((D,)),
    }


def reference(x, c, positions, w_ada, b_ada, g_mix, w_in, g_q, w_uq, g_kv, w_uk, w_uv,
              rel_bias, w_oa, w_ob, w_out, g_ffn, w_rg, b_rg, w_re, b_re,
              w_gate, w_up, w_down, g_final):
    c_act = jax.nn.silu(c)
    for l in range(DEPTH):
        mod = c_act @ w_ada[l] + b_ada[l]
        sh1, sc1, gt1, sh2, sc2, gt2 = jnp.split(mod, N_MOD, axis=-1)
        h = modulate(rms_norm(x, g_mix[l]), sh1, sc1)
        mix = hybrid_mixer(h, positions, w_in[l], g_q[l], w_uq[l], g_kv[l], w_uk[l], w_uv[l],
                           rel_bias[l], w_oa[l], w_ob[l], w_out[l])
        x = x + gt1[:, None, :] * mix
        h = modulate(rms_norm(x, g_ffn[l]), sh2, sc2)
        ffn = hierarchical_moe(h, w_rg[l], b_rg[l], w_re[l], b_re[l], w_gate[l], w_up[l], w_down[l])
        x = x + gt2[:, None, :] * ffn
    return rms_norm(x, g_final)
```

```cpp
#include <hip/hip_runtime.h>
#include <cstdio>
#include <cstdint>
namespace nv {
constexpr int D = 1024, NB = 8, S = 4096, INW = 4000;
constexpr int C_QLAT = 0, C_KVLAT = 256, C_KROPE = 384, C_QB = 416, C_KB = 928, C_VB = 1440, C_GA = 1952, C_GB = 2976;

__device__ __forceinline__ float block_sum_256(float v, float* red) {
#pragma unroll
    for (int o = 32; o > 0; o >>= 1) v += __shfl_xor(v, o);
    const int w = threadIdx.x >> 6;
    __syncthreads();
    if ((threadIdx.x & 63) == 0) red[w] = v;
    __syncthreads();
    return red[0] + red[1] + red[2] + red[3];
}

__global__ void __launch_bounds__(256) k_mod(const float* c, const float* w_ada, const float* b_ada, float* mod) {
    const int n = blockIdx.x * 256 + threadIdx.x, b = blockIdx.y;
    float acc = 0.f;
    for (int k = 0; k < 1024; ++k) { const float cv = c[b * 1024 + k]; const float s = cv / (1.f + expf(-cv)); acc += s * w_ada[(size_t)k * 6144 + n]; }
    mod[b * 6144 + n] = acc + b_ada[n];
}

__global__ void __launch_bounds__(256) k_norm_mod(const float* x, const float* g, const float* shift, const float* scale, float* out) {
    __shared__ float red[4];
    const int r = blockIdx.x; const float* xr = x + (size_t)r * 1024; float* orow = out + (size_t)r * 1024;
    float v0 = xr[threadIdx.x], v1 = xr[threadIdx.x + 256], v2 = xr[threadIdx.x + 512], v3 = xr[threadIdx.x + 768];
    const float tot = block_sum_256(v0 * v0 + v1 * v1 + v2 * v2 + v3 * v3, red);
    const float inv = 1.0f / sqrtf(tot * (1.f / 1024.f) + 1e-6f);
#define NV_ONE(v, cc) { const int col = (cc); float y = v * inv * g[col]; if (scale) y = y * (1.f + scale[col]) + shift[col]; orow[col] = y; }
    NV_ONE(v0, threadIdx.x) NV_ONE(v1, threadIdx.x + 256) NV_ONE(v2, threadIdx.x + 512) NV_ONE(v3, threadIdx.x + 768)
#undef NV_ONE
}

__global__ void __launch_bounds__(64) k_rms_rows(const float* in, int ld, int n, const float* g, float* out, int ldo) {
    const int r = blockIdx.x, l = threadIdx.x; const float* ir = in + (size_t)r * ld;
    float ss = 0.f;
    for (int c = l; c < n; c += 64) { const float v = ir[c]; ss += v * v; }
#pragma unroll
    for (int o = 32; o > 0; o >>= 1) ss += __shfl_xor(ss, o);
    const float inv = 1.0f / sqrtf(ss / (float)n + 1e-6f);
    for (int c = l; c < n; c += 64) out[(size_t)r * ldo + c] = ir[c] * inv * g[c];
}

__global__ void __launch_bounds__(256) k_gemm(const float* A, int lda, const float* Bm, int ldb, float* C, int ldc, int M, int N, int K) {
    __shared__ float As[16][65]; __shared__ float Bs[16][64];
    const int tid = threadIdx.x, tx = tid & 15, ty = tid >> 4;
    const int m0 = blockIdx.y * 64, n0 = blockIdx.x * 64;
    float acc[4][4];
#pragma unroll
    for (int i = 0; i < 4; ++i)
#pragma unroll
        for (int j = 0; j < 4; ++j) acc[i][j] = 0.f;
    for (int k0 = 0; k0 < K; k0 += 16) {
#pragma unroll
        for (int i = 0; i < 4; ++i) { const int idx = tid + 256 * i; const int r = idx >> 4, kk = idx & 15; As[kk][r] = A[(size_t)(m0 + r) * lda + k0 + kk]; }
#pragma unroll
        for (int i = 0; i < 4; ++i) { const int idx = tid + 256 * i; const int kk = idx >> 6, cc = idx & 63; Bs[kk][cc] = (n0 + cc < N) ? Bm[(size_t)(k0 + kk) * ldb + n0 + cc] : 0.f; }
        __syncthreads();
#pragma unroll
        for (int kk = 0; kk < 16; ++kk) {
            float a[4], b[4];
#pragma unroll
            for (int i = 0; i < 4; ++i) a[i] = As[kk][ty * 4 + i];
#pragma unroll
            for (int j = 0; j < 4; ++j) b[j] = Bs[kk][tx * 4 + j];
#pragma unroll
            for (int i = 0; i < 4; ++i)
#pragma unroll
                for (int j = 0; j < 4; ++j) acc[i][j] += a[i] * b[j];
        }
        __syncthreads();
    }
#pragma unroll
    for (int i = 0; i < 4; ++i)
#pragma unroll
        for (int j = 0; j < 4; ++j) { const int col = n0 + tx * 4 + j; if (col < N) C[(size_t)(m0 + ty * 4 + i) * ldc + col] = acc[i][j]; }
}

__global__ void __launch_bounds__(256) k_rope(float* qa, const float* proj, float* kr, const int* pos  ) {
    const int idx = blockIdx.x * 256 + threadIdx.x;
    const int i = idx & 15, w = (idx >> 4) % 9, r = idx / 144;
    if (r >= S) return;
    const float inv = powf(10000.0f, -(float)i / 16.0f);
    const float ang = (float)pos[r] * inv;
    const float cs = cosf(ang), sn = sinf(ang);
    if (w < 8) { float* p = qa + (size_t)r * 768 + w * 96 + 64; const float x1 = p[i], x2 = p[i + 16]; p[i] = x1 * cs - x2 * sn; p[i + 16] = x2 * cs + x1 * sn; }
    else { const float* p = proj + (size_t)r * INW + C_KROPE; const float x1 = p[i], x2 = p[i + 16]; kr[r * 32 + i] = x1 * cs - x2 * sn; kr[r * 32 + i + 16] = x2 * cs + x1 * sn; }
}

__global__ void __launch_bounds__(64) k_mla(const float* qa, const float* kn, const float* kr, const float* va, float* oa) {
    const int c = blockIdx.x, h = blockIdx.y, q = c * 64 + threadIdx.x;
    float qv[96];
#pragma unroll
    for (int d = 0; d < 96; ++d) qv[d] = qa[(size_t)q * 768 + h * 96 + d];
    float m = -1e30f, l = 0.f, o[64];
#pragma unroll
    for (int d = 0; d < 64; ++d) o[d] = 0.f;
    const int nk = (c + 1) * 64;
    const float scale = 0.10206207261596577f;
    for (int k = 0; k < nk; ++k) {
        const float* kp = kn + (size_t)k * 512 + h * 64; const float* rp = kr + (size_t)k * 32; const float* vp = va + (size_t)k * 512 + h * 64;
        float s = 0.f;
#pragma unroll
        for (int d = 0; d < 64; ++d) s += qv[d] * kp[d];
#pragma unroll
        for (int d = 0; d < 32; ++d) s += qv[64 + d] * rp[d];
        s *= scale;
        const float mn = fmaxf(m, s), corr = expf(m - mn), p = expf(s - mn);
        l = l * corr + p;
#pragma unroll
        for (int d = 0; d < 64; ++d) o[d] = o[d] * corr + p * vp[d];
        m = mn;
    }
    const float il = 1.f / l;
#pragma unroll
    for (int d = 0; d < 64; ++d) oa[(size_t)q * 512 + h * 64 + d] = o[d] * il;
}

__global__ void __launch_bounds__(64) k_band(const float* proj, const float* rel  , float* ob) {
    const int c = blockIdx.x, h = blockIdx.y, q = c * 64 + threadIdx.x;
    float qv[64];
#pragma unroll
    for (int d = 0; d < 64; ++d) qv[d] = proj[(size_t)q * INW + C_QB + h * 64 + d];
    float m = -1e30f, l = 0.f, o[64];
#pragma unroll
    for (int d = 0; d < 64; ++d) o[d] = 0.f;
    const int k0 = (c - 8) * 64 < 0 ? 0 : (c - 8) * 64, k1 = (c + 1) * 64;
    for (int k = k0; k < k1; ++k) {
        const float* kp = proj + (size_t)k * INW + C_KB + h * 64; const float* vp = proj + (size_t)k * INW + C_VB + h * 64;
        float s = 0.f;
#pragma unroll
        for (int d = 0; d < 64; ++d) s += qv[d] * kp[d];
        int rl = q - k; rl = rl < -256 ? -256 : (rl > 256 ? 256 : rl);
        s = s * 0.125f + rel[h * 513 + rl + 256];
        const float mn = fmaxf(m, s), corr = expf(m - mn), p = expf(s - mn);
        l = l * corr + p;
#pragma unroll
        for (int d = 0; d < 64; ++d) o[d] = o[d] * corr + p * vp[d];
        m = mn;
    }
    const float il = 1.f / l;
#pragma unroll
    for (int d = 0; d < 64; ++d) ob[(size_t)q * 512 + h * 64 + d] = o[d] * il;
}

__global__ void __launch_bounds__(256) k_merge(float* A, const float* Bm, const float* proj) {
    const size_t idx = (size_t)blockIdx.x * 256 + threadIdx.x; const int r = (int)(idx >> 10), col = (int)(idx & 1023);
    const float ga = proj[(size_t)r * INW + C_GA + col], gb = proj[(size_t)r * INW + C_GB + col];
    A[idx] = A[idx] / (1.f + expf(-ga)) + Bm[idx] / (1.f + expf(-gb));
}
__global__ void __launch_bounds__(256) k_resid(const float* x, const float* gate, const float* mix, float* x1) {
    const size_t idx = (size_t)blockIdx.x * 256 + threadIdx.x; const int col = (int)(idx & 1023);
    x1[idx] = x[idx] + gate[col] * mix[idx];
}

__global__ void __launch_bounds__(64) k_route(const float* h2, const float* w_rg, const float* b_rg, const float* w_re, const float* b_re, int* rt_e, float* rt_w) {
    const int r = blockIdx.x, l = threadIdx.x; const float* hr = h2 + (size_t)r * 1024;
    float lg[36];
#pragma unroll
    for (int j = 0; j < 36; ++j) lg[j] = 0.f;
    for (int k = l; k < 1024; k += 64) { const float hv = hr[k];
#pragma unroll
        for (int j = 0; j < 4; ++j) lg[j] += hv * w_rg[k * 4 + j];
#pragma unroll
        for (int j = 0; j < 32; ++j) lg[4 + j] += hv * w_re[k * 32 + j]; }
#pragma unroll
    for (int j = 0; j < 36; ++j) {
#pragma unroll
        for (int o = 32; o > 0; o >>= 1) lg[j] += __shfl_xor(lg[j], o); }
    float gmax = -1e30f; int gi = 0;
#pragma unroll
    for (int j = 0; j < 4; ++j) { lg[j] += b_rg[j]; if (lg[j] > gmax) { gmax = lg[j]; gi = j; } }
    float gs = 0.f;
#pragma unroll
    for (int j = 0; j < 4; ++j) gs += expf(lg[j] - gmax);
    const float gw = 1.f / gs;
    float e[8];
#pragma unroll
    for (int j = 0; j < 8; ++j) { float v = 0.f;
#pragma unroll
        for (int g = 0; g < 4; ++g) v = (g == gi) ? (lg[4 + g * 8 + j] + b_re[g * 8 + j]) : v;
        e[j] = v; }
    float m1 = -1e30f; int i1 = 0;
#pragma unroll
    for (int j = 0; j < 8; ++j) if (e[j] > m1) { m1 = e[j]; i1 = j; }
    float m2 = -1e30f; int i2 = 0;
#pragma unroll
    for (int j = 0; j < 8; ++j) if (j != i1 && e[j] > m2) { m2 = e[j]; i2 = j; }
    const float p2 = expf(m2 - m1); const float w1 = 1.f / (1.f + p2), w2 = p2 / (1.f + p2);
    if (l == 0) { rt_e[r * 2] = gi * 8 + i1; rt_e[r * 2 + 1] = gi * 8 + i2; rt_w[r * 2] = w1 * gw; rt_w[r * 2 + 1] = w2 * gw; }
}

__global__ void __launch_bounds__(256) k_moe(const float* h2, const int* rt_e, const float* rt_w, const float* w_gate, const float* w_up, const float* w_down, float* y) {
    __shared__ float hs[1024]; __shared__ float hid[256];
    const int r = blockIdx.x, t = threadIdx.x;
#pragma unroll
    for (int i = 0; i < 4; ++i) hs[t + 256 * i] = h2[(size_t)r * 1024 + t + 256 * i];
    float y0 = 0.f, y1 = 0.f, y2 = 0.f, y3 = 0.f;
    for (int k = 0; k < 2; ++k) {
        const int e = rt_e[r * 2 + k]; const float w = rt_w[r * 2 + k];
        const float* wg = w_gate + (size_t)e * 1024 * 256; const float* wu = w_up + (size_t)e * 1024 * 256; const float* wd = w_down + (size_t)e * 256 * 1024;
        __syncthreads();
        float a = 0.f, u = 0.f;
        for (int d = 0; d < 1024; ++d) { const float hv = hs[d]; a += hv * wg[(size_t)d * 256 + t]; u += hv * wu[(size_t)d * 256 + t]; }
        hid[t] = a / (1.f + expf(-a)) * u * w;
        __syncthreads();
        for (int f = 0; f < 256; ++f) { const float hv = hid[f]; const float* wr = wd + (size_t)f * 1024;
            y0 += hv * wr[t]; y1 += hv * wr[t + 256]; y2 += hv * wr[t + 512]; y3 += hv * wr[t + 768]; }
    }
    float* yr = y + (size_t)r * 1024; yr[t] = y0; yr[t + 256] = y1; yr[t + 512] = y2; yr[t + 768] = y3;
}

__global__ void __launch_bounds__(256) k_final(const float* x1, const float* gate, const float* y, const float* g, float* out) {
    __shared__ float red[4];
    const int r = blockIdx.x; const size_t base = (size_t)r * 1024;
    float v[4];
#pragma unroll
    for (int i = 0; i < 4; ++i) { const int col = threadIdx.x + 256 * i; v[i] = x1[base + col] + gate[col] * y[base + col]; }
    const float tot = block_sum_256(v[0] * v[0] + v[1] * v[1] + v[2] * v[2] + v[3] * v[3], red);
    const float inv = 1.0f / sqrtf(tot * (1.f / 1024.f) + 1e-6f);
#pragma unroll
    for (int i = 0; i < 4; ++i) { const int col = threadIdx.x + 256 * i; out[base + col] = v[i] * inv * g[col]; }
}

struct In {
    const float *x, *c; const int* pos; const float *w_ada, *b_ada, *g_mix, *w_in, *g_q, *w_uq, *g_kv, *w_uk, *w_uv, *rel, *w_oa, *w_ob, *w_out, *g_ffn, *w_rg, *b_rg, *w_re, *b_re, *w_gate, *w_up, *w_down, *g_final;
};
struct Scratch {
    float *mod, *h, *proj, *qn, *kvn, *qa, *kn, *va, *kr, *oa, *ob, *A, *Bm, *mix, *x1, *h2, *y, *rt_w; int* rt_e;
    size_t carve(float* base) {
        size_t o = 0; auto take = [&](size_t n) { float* p = base + o; o += (n + 63) & ~(size_t)63; return p; };
        mod = take(8 * 6144); h = take((size_t)S * 1024); proj = take((size_t)S * INW); qn = take((size_t)S * 256); kvn = take((size_t)S * 128);
        qa = take((size_t)S * 768); kn = take((size_t)S * 512); va = take((size_t)S * 512); kr = take((size_t)S * 32);
        oa = take((size_t)S * 512); ob = take((size_t)S * 512); A = take((size_t)S * 1024); Bm = take((size_t)S * 1024); mix = take((size_t)S * 1024);
        x1 = take((size_t)S * 1024); h2 = take((size_t)S * 1024); y = take((size_t)S * 1024); rt_w = take((size_t)S * 2); rt_e = (int*)take((size_t)S * 2);
        return o;
    }
};

static void gemm(const float* A, int lda, const float* Bm, int ldb, float* C, int ldc, int M, int N, int K, hipStream_t st) {
    hipLaunchKernelGGL(k_gemm, dim3((N + 63) / 64, M / 64), dim3(256), 0, st, A, lda, Bm, ldb, C, ldc, M, N, K);
}

static void forward_batch(const In& in, const Scratch& sc, int b, float* out, hipStream_t st) {
    const float* xb = in.x + (size_t)b * S * D; float* ob_ = out + (size_t)b * S * D;
    const float* mod = sc.mod + (size_t)b * 6144;
    const float *sh1 = mod, *sc1 = mod + 1024, *gt1 = mod + 2048, *sh2 = mod + 3072, *sc2 = mod + 4096, *gt2 = mod + 5120;
    hipLaunchKernelGGL(k_norm_mod, dim3(S), dim3(256), 0, st, xb, in.g_mix, sh1, sc1, sc.h);
    gemm(sc.h, 1024, in.w_in, INW, sc.proj, INW, S, INW, 1024, st);
    hipLaunchKernelGGL(k_rms_rows, dim3(S), dim3(64), 0, st, sc.proj + C_QLAT, INW, 256, in.g_q, sc.qn, 256);
    hipLaunchKernelGGL(k_rms_rows, dim3(S), dim3(64), 0, st, sc.proj + C_KVLAT, INW, 128, in.g_kv, sc.kvn, 128);
    gemm(sc.qn, 256, in.w_uq, 768, sc.qa, 768, S, 768, 256, st);
    gemm(sc.kvn, 128, in.w_uk, 512, sc.kn, 512, S, 512, 128, st);
    gemm(sc.kvn, 128, in.w_uv, 512, sc.va, 512, S, 512, 128, st);
    hipLaunchKernelGGL(k_rope, dim3((S * 144 + 255) / 256), dim3(256), 0, st, sc.qa, sc.proj, sc.kr, in.pos + (size_t)b * S);
    hipLaunchKernelGGL(k_mla, dim3(S / 64, 8), dim3(64), 0, st, sc.qa, sc.kn, sc.kr, sc.va, sc.oa);
    hipLaunchKernelGGL(k_band, dim3(S / 64, 8), dim3(64), 0, st, sc.proj, in.rel, sc.ob);
    gemm(sc.oa, 512, in.w_oa, 1024, sc.A, 1024, S, 1024, 512, st);
    gemm(sc.ob, 512, in.w_ob, 1024, sc.Bm, 1024, S, 1024, 512, st);
    hipLaunchKernelGGL(k_merge, dim3(S * 1024 / 256), dim3(256), 0, st, sc.A, sc.Bm, sc.proj);
    gemm(sc.A, 1024, in.w_out, 1024, sc.mix, 1024, S, 1024, 1024, st);
    hipLaunchKernelGGL(k_resid, dim3(S * 1024 / 256), dim3(256), 0, st, xb, gt1, sc.mix, sc.x1);
    hipLaunchKernelGGL(k_norm_mod, dim3(S), dim3(256), 0, st, sc.x1, in.g_ffn, sh2, sc2, sc.h2);
    hipLaunchKernelGGL(k_route, dim3(S), dim3(64), 0, st, sc.h2, in.w_rg, in.b_rg, in.w_re, in.b_re, sc.rt_e, sc.rt_w);
    hipLaunchKernelGGL(k_moe, dim3(S), dim3(256), 0, st, sc.h2, sc.rt_e, sc.rt_w, in.w_gate, in.w_up, in.w_down, sc.y);
    hipLaunchKernelGGL(k_final, dim3(S), dim3(256), 0, st, sc.x1, gt2, sc.y, in.g_final, ob_);
}
static void fill_in(In& in, void* const* d_in) {
    in.x = (const float*)d_in[0]; in.c = (const float*)d_in[1]; in.pos = (const int*)d_in[2]; in.w_ada = (const float*)d_in[3]; in.b_ada = (const float*)d_in[4];
    in.g_mix = (const float*)d_in[5]; in.w_in = (const float*)d_in[6]; in.g_q = (const float*)d_in[7]; in.w_uq = (const float*)d_in[8]; in.g_kv = (const float*)d_in[9];
    in.w_uk = (const float*)d_in[10]; in.w_uv = (const float*)d_in[11]; in.rel = (const float*)d_in[12]; in.w_oa = (const float*)d_in[13]; in.w_ob = (const float*)d_in[14];
    in.w_out = (const float*)d_in[15]; in.g_ffn = (const float*)d_in[16]; in.w_rg = (const float*)d_in[17]; in.b_rg = (const float*)d_in[18]; in.w_re = (const float*)d_in[19];
    in.b_re = (const float*)d_in[20]; in.w_gate = (const float*)d_in[21]; in.w_up = (const float*)d_in[22]; in.w_down = (const float*)d_in[23]; in.g_final = (const float*)d_in[24];
}
}
extern "C" void kernel_launch(void* const* d_in, const int* in_sizes, int n_in, void* d_out, int out_size, void* d_ws, size_t ws_size, hipStream_t stream) {
    nv::In in; nv::fill_in(in, d_in);
    nv::Scratch sc; sc.carve((float*)d_ws);
    hipLaunchKernelGGL(nv::k_mod, dim3(6144 / 256, 8), dim3(256), 0, stream, in.c, in.w_ada, in.b_ada, sc.mod);
    for (int b = 0; b < nv::NB; ++b) nv::forward_batch(in, sc, b, (float*)d_out, stream);
}
```

```cpp
#include <hip/hip_runtime.h>
#include <hip/hip_bf16.h>
#include <cstdio>
#include <cstdint>
#include <cmath>
namespace pg8 {
#define PG8_LAS __attribute__((address_space(3)))
typedef unsigned short bf16_t;
typedef short bf16x8 __attribute__((ext_vector_type(8)));
typedef float f32x4 __attribute__((ext_vector_type(4)));
typedef unsigned u32x4 __attribute__((ext_vector_type(4)));
constexpr int BM = 256, BK = 64, HALF = 128, HTB = HALF * BK * 2  , STAGE_BYTES = 8 * HTB, NXCD = 8, WGM = 8;

__host__ __device__ __forceinline__ int lds_byte(int r, int c) { const int st = (r >> 4) * 2 + (c >> 5), rr = r & 15, cc = c & 31, ob = rr * 64 + cc * 2; return st * 1024 + (ob ^ (((ob >> 9) & 1) << 5)); }
__host__ __device__ __forceinline__ void stage_rc(int b, int& R, int& C) { const int st = b / 1024, sb = b % 1024, swz = sb ^ (((sb >> 9) & 1) << 5); R = (st >> 1) * 16 + swz / 64; C = (st & 1) * 32 + (swz % 64) / 2; }
__host__ __device__ __forceinline__ int perm32(int rho) { const int n = rho >> 4, i = rho & 15; return 8 * (i >> 2) + 4 * n + (i & 3); }

struct Unit { int pm, pn; };
struct Gemm { const bf16_t* A; const bf16_t* Bt; int M, N, K; };

struct StaticOrder {
    static constexpr bool GATHER = false; __device__ __forceinline__ unsigned a_row_off(int) const { return 0u; }
    int nM, nN, nwg, G, c;
    __host__ __device__ void init(int M, int N, int G_, int c_) { nM = M / BM; nN = N / BM; nwg = nM * nN; G = G_; c = c_; }
    __host__ __device__ bool next(int i, Unit& u) const {
        const long L = (long)i * G + c; if (L >= nwg) return false;
        int wgid = (int)L; { const int q = nwg / NXCD, r = nwg % NXCD, xcd = wgid % NXCD, off = wgid / NXCD; wgid = (xcd < r ? xcd * (q + 1) : r * (q + 1) + (xcd - r) * q) + off; }
        const int nig = WGM * nN, gid = wgid / nig, fm = gid * WGM, gsz = (nM - fm) < WGM ? (nM - fm) : WGM;
        u.pm = fm + ((wgid % nig) % gsz); u.pn = (wgid % nig) / gsz; return true;
    }
    __device__ __forceinline__ void a_ready(const Unit&) const {}
    __device__ __forceinline__ void done(const Unit&) const {}
};
__device__ __forceinline__ unsigned cvt_pk_bf16(float lo, float hi) { unsigned r; asm volatile("v_cvt_pk_bf16_f32 %0, %1, %2" : "=v"(r) : "v"(lo), "v"(hi)); return r; }
typedef float f32x2 __attribute__((ext_vector_type(2)));
template <class Epi, class Sched, bool ALIGN_EPI = false, bool SP2 = false>
__device__ __forceinline__ void gemm_phase(PG8_LAS unsigned char* lds, const Gemm g, const Sched& S, const Epi& E) {
    const int tid = threadIdx.x, wid = __builtin_amdgcn_readfirstlane(tid >> 6), lane = tid & 63, wr = wid >> 2, wc = wid & 3, fr = lane & 15, fq = lane >> 4;
    const int K = g.K, nt = K / BK;
    unsigned voffA[2], voffB[2];
    constexpr bool GA = Sched::GATHER;
    unsigned gC[2][2] = {{0u, 0u}, {0u, 0u}}, gN[2][2] = {{0u, 0u}, {0u, 0u}}; int gR[2] = {0, 0}; unsigned gCc[2] = {0u, 0u};
#pragma unroll
    for (int i = 0; i < 2; ++i) { int R, C; stage_rc(tid * 16 + i * 8192, R, C); const int Rb = Epi::PERM ? ((R & ~31) + perm32(R & 31)) : R;
        voffA[i] = (unsigned)(R * K + C) * 2u; voffB[i] = (unsigned)(Rb * K + C) * 2u; gR[i] = R; gCc[i] = (unsigned)C * 2u; }
#define PG8_GOFF(dst, u) do { _Pragma("unroll") for (int h_ = 0; h_ < 2; ++h_) _Pragma("unroll") for (int i_ = 0; i_ < 2; ++i_) dst[h_][i_] = S.a_row_off((u).pm * BM + h_ * HALF + gR[i_]) + gCc[i_]; } while (0)
#define PG8_STAGE_A(bufoff, h, base, nx) do { if constexpr (GA) { unsigned vv_[2] = {(nx) ? gN[h][0] : gC[h][0], (nx) ? gN[h][1] : gC[h][1]}; PG8_STAGE(bufoff, base, vv_); } else { PG8_STAGE(bufoff, (base) + (h) * hstep, voffA); } } while (0)
    const size_t kstep = (size_t)(BK * 2);
    const size_t hstep = (size_t)HALF * K * 2;
    const size_t tstep = 2 * hstep;
    const unsigned ldsw = (unsigned)wid * 1024u;
    const int aoff = lds_byte(wr * 64 + fr, fq * 8), boff = lds_byte(wc * 32 + fr, fq * 8);
#define PG8_SA(b, h) (((b) * 2 + (h)) * HTB)
#define PG8_SB(b, h) ((4 + (b) * 2 + (h)) * HTB)
#define PG8_STAGE(bufoff, gbase, voff) do { _Pragma("unroll") for (int _i = 0; _i < 2; ++_i) \
        __builtin_amdgcn_global_load_lds((const unsigned*)((const char*)(gbase) + (voff)[_i]), (PG8_LAS unsigned*)(lds + (bufoff) + ldsw + _i * 8192), 16, 0, 0); } while (0)
#define PG8_LDA(dst, b, h) do { _Pragma("unroll") for (int m = 0; m < 4; ++m) _Pragma("unroll") for (int k = 0; k < 2; ++k) dst[m][k] = *(const PG8_LAS bf16x8*)(lds + PG8_SA(b, h) + aoff + m * 2048 + k * 1024); } while (0)
#define PG8_LDB(dst, b, h) do { _Pragma("unroll") for (int n = 0; n < 2; ++n) _Pragma("unroll") for (int k = 0; k < 2; ++k) dst[n][k] = *(const PG8_LAS bf16x8*)(lds + PG8_SB(b, h) + boff + n * 2048 + k * 1024); } while (0)
#define PG8_MMA(ai, bj, At, Bt) do { __builtin_amdgcn_s_setprio(1); _Pragma("unroll") for (int m = 0; m < 4; ++m) _Pragma("unroll") for (int n = 0; n < 2; ++n) _Pragma("unroll") for (int k = 0; k < 2; ++k) \
        acc[ai][bj][m][n] = __builtin_amdgcn_mfma_f32_16x16x32_bf16(Bt[n][k], At[m][k], acc[ai][bj][m][n], 0, 0, 0); __builtin_amdgcn_s_setprio(0); } while (0)
#define PG8_WAIT_V(n) asm volatile("s_waitcnt vmcnt(" #n ")" ::: "memory")
#define PG8_WAIT_L(n) asm volatile("s_waitcnt lgkmcnt(" #n ")" ::: "memory")
#define PG8_BAR __builtin_amdgcn_s_barrier()
#define PG8_SCHED __builtin_amdgcn_sched_barrier(0)
    Unit cur, nxt; int ui = 0;
    if (!S.next(0, cur)) return;
    f32x4 acc[2][2][4][2];
#pragma unroll
    for (int a = 0; a < 2; ++a)
#pragma unroll
        for (int b = 0; b < 2; ++b)
#pragma unroll
            for (int m = 0; m < 4; ++m)
#pragma unroll
                for (int n = 0; n < 2; ++n) acc[a][b][m][n] = (f32x4){0.f, 0.f, 0.f, 0.f};
    bf16x8 At[4][2], B0[2][2], B1[2][2];
    const char* cA = (const char*)g.A + (GA ? (size_t)0 : (size_t)cur.pm * tstep); const char* cB = (const char*)g.Bt + (size_t)cur.pn * tstep;
    if constexpr (GA) PG8_GOFF(gC, cur);
    S.a_ready(cur);
    static_assert(SP2 || !GA, "gathered A rows: SP2 loop only");
    if constexpr (SP2) {
        PG8_STAGE(PG8_SB(0, 0), cB, voffB); PG8_STAGE(PG8_SB(0, 1), cB + hstep, voffB); PG8_STAGE_A(PG8_SA(0, 0), 0, cA, false); PG8_STAGE_A(PG8_SA(0, 1), 1, cA, false);
        if (wr == 1) PG8_BAR;
        PG8_WAIT_V(2); PG8_BAR;
        PG8_STAGE(PG8_SB(1, 0), cB + kstep, voffB); PG8_STAGE_A(PG8_SA(1, 0), 0, cA + kstep, false); PG8_STAGE(PG8_SB(1, 1), cB + hstep + kstep, voffB);
        PG8_WAIT_V(6); PG8_BAR;
    } else {
        PG8_STAGE(PG8_SB(0, 0), cB, voffB); PG8_STAGE(PG8_SA(0, 0), cA, voffA); PG8_STAGE(PG8_SB(0, 1), cB + hstep, voffB); PG8_STAGE(PG8_SA(0, 1), cA + hstep, voffA);
        if (wr == 1) PG8_BAR;
        PG8_WAIT_V(4); PG8_BAR;
        PG8_STAGE(PG8_SB(1, 0), cB + kstep, voffB); PG8_STAGE(PG8_SA(1, 0), cA + kstep, voffA); PG8_STAGE(PG8_SB(1, 1), cB + hstep + kstep, voffB);
        PG8_WAIT_V(6); PG8_BAR;
    }
    for (;;) {
        const bool has_next = S.next(ui + 1, nxt);
        const char* nA = (has_next && !GA) ? (const char*)g.A + (size_t)nxt.pm * tstep : cA; if constexpr (GA) { if (has_next) PG8_GOFF(gN, nxt); }
        const char* nB = has_next ? (const char*)g.Bt + (size_t)nxt.pn * tstep : cB;
        _Pragma("unroll 1") for (int t = 0; t < nt; t += 2) {
            const bool last = (t == nt - 2);
            const char* a1 = cA + (size_t)(t + 1) * kstep;
            const char* a2 = last ? nA : cA + (size_t)(t + 2) * kstep; const char* b2 = last ? nB : cB + (size_t)(t + 2) * kstep;
            const char* a3 = a2 + kstep; const char* b3 = b2 + kstep;
            if (last && has_next) S.a_ready(nxt);
            if constexpr (SP2) {
            PG8_LDB(B0, 0, 0); PG8_LDB(B1, 0, 1); PG8_SCHED; PG8_LDA(At, 0, 0); PG8_STAGE_A(PG8_SA(1, 1), 1, a1, false);
            PG8_WAIT_V(8); PG8_WAIT_L(0); PG8_BAR; PG8_MMA(0, 0, At, B0); PG8_MMA(0, 1, At, B1); PG8_BAR; PG8_SCHED;
            PG8_LDA(At, 0, 1); PG8_STAGE(PG8_SB(0, 0), b2, voffB); PG8_STAGE(PG8_SB(0, 1), b2 + hstep, voffB); PG8_STAGE_A(PG8_SA(0, 0), 0, a2, last && has_next);
            PG8_WAIT_V(8); PG8_WAIT_L(0); PG8_BAR; PG8_MMA(1, 0, At, B0); PG8_MMA(1, 1, At, B1); PG8_BAR; PG8_SCHED;
            PG8_LDB(B0, 1, 0); PG8_LDB(B1, 1, 1); PG8_SCHED; PG8_LDA(At, 1, 0); PG8_STAGE_A(PG8_SA(0, 1), 1, a2, last && has_next);
            PG8_WAIT_V(8); PG8_WAIT_L(0); PG8_BAR; PG8_MMA(0, 0, At, B0); PG8_MMA(0, 1, At, B1); PG8_BAR; PG8_SCHED;
            PG8_LDA(At, 1, 1); PG8_STAGE(PG8_SB(1, 0), b3, voffB); PG8_STAGE(PG8_SB(1, 1), b3 + hstep, voffB); PG8_STAGE_A(PG8_SA(1, 0), 0, a3, last && has_next);
            PG8_WAIT_V(8); PG8_WAIT_L(0); PG8_BAR; PG8_MMA(1, 0, At, B0); PG8_MMA(1, 1, At, B1); PG8_BAR; PG8_SCHED;
            } else {
            PG8_LDB(B0, 0, 0); PG8_SCHED; PG8_LDA(At, 0, 0); PG8_STAGE(PG8_SA(1, 1), a1 + hstep, voffA);
            PG8_WAIT_L(8); PG8_BAR; PG8_WAIT_L(0); PG8_MMA(0, 0, At, B0); PG8_BAR; PG8_SCHED;
            PG8_LDB(B1, 0, 1); PG8_STAGE(PG8_SB(0, 0), b2, voffB);
            PG8_BAR; PG8_WAIT_L(0); PG8_MMA(0, 1, At, B1); PG8_BAR;
            PG8_LDA(At, 0, 1); PG8_STAGE(PG8_SA(0, 0), a2, voffA);
            PG8_BAR; PG8_WAIT_L(0); PG8_MMA(1, 0, At, B0); PG8_BAR; PG8_SCHED;
            PG8_STAGE(PG8_SB(0, 1), b2 + hstep, voffB);
            PG8_WAIT_V(6); PG8_BAR; PG8_MMA(1, 1, At, B1); PG8_BAR;
            PG8_LDB(B0, 1, 0); PG8_SCHED; PG8_LDA(At, 1, 0); PG8_STAGE(PG8_SA(0, 1), a2 + hstep, voffA);
            PG8_WAIT_L(8); PG8_BAR; PG8_WAIT_L(0); PG8_MMA(0, 0, At, B0); PG8_BAR; PG8_SCHED;
            PG8_LDB(B1, 1, 1); PG8_STAGE(PG8_SB(1, 0), b3, voffB);
            PG8_BAR; PG8_WAIT_L(0); PG8_MMA(0, 1, At, B1); PG8_BAR;
            PG8_LDA(At, 1, 1); PG8_STAGE(PG8_SA(1, 0), a3, voffA);
            PG8_BAR; PG8_WAIT_L(0); PG8_MMA(1, 0, At, B0); PG8_BAR; PG8_SCHED;
            PG8_STAGE(PG8_SB(1, 1), b3 + hstep, voffB);
            PG8_WAIT_V(6); PG8_BAR; PG8_MMA(1, 1, At, B1); PG8_BAR;
            }
        }
        if constexpr (ALIGN_EPI) { if (wr == 0) PG8_BAR; }
        bool kept = false;
        if constexpr (!Epi::AFTER_DRAIN) {
            if constexpr (Epi::MID) { if (E.is_mid(cur)) { E.mid(acc, cur, wr, wc, fr, fq); kept = true; } else E(acc, cur, wr, wc, fr, fq); }
            else E(acc, cur, wr, wc, fr, fq);
            S.done(cur); }
        if (!has_next) break;
        if (!kept)
#pragma unroll
        for (int a = 0; a < 2; ++a)
#pragma unroll
            for (int b = 0; b < 2; ++b)
#pragma unroll
                for (int m = 0; m < 4; ++m)
#pragma unroll
                    for (int n = 0; n < 2; ++n) acc[a][b][m][n] = (f32x4){0.f, 0.f, 0.f, 0.f};
        cur = nxt; cA = nA; cB = nB; ++ui;
        if constexpr (GA) { _Pragma("unroll") for (int h_ = 0; h_ < 2; ++h_) _Pragma("unroll") for (int i_ = 0; i_ < 2; ++i_) gC[h_][i_] = gN[h_][i_]; }
        if constexpr (ALIGN_EPI) { if (wr == 1) PG8_BAR; }
    }
    PG8_WAIT_V(0);
    if constexpr (!ALIGN_EPI) { if (wr == 0) PG8_BAR; }
    PG8_BAR;
    if constexpr (Epi::AFTER_DRAIN) { E.fused(acc, cur, wr, wc, fr, fq, lds, wid, lane); S.done(cur); }
#undef PG8_SA
#undef PG8_GOFF
#undef PG8_STAGE_A
#undef PG8_SB
#undef PG8_STAGE
#undef PG8_LDA
#undef PG8_LDB
#undef PG8_MMA
#undef PG8_WAIT_V
#undef PG8_WAIT_L
#undef PG8_BAR
#undef PG8_SCHED
}
}
#define GAS __attribute__((address_space(1)))
#define LAS __attribute__((address_space(3)))
typedef unsigned short bf16;
typedef unsigned v4u __attribute__((ext_vector_type(4)));
typedef float f32x4 __attribute__((ext_vector_type(4)));
typedef short bf16x8 __attribute__((ext_vector_type(8)));
typedef GAS unsigned gu32;
typedef GAS unsigned long long gu64;
#define RLX_AGENT __ATOMIC_RELAXED, __HIP_MEMORY_SCOPE_AGENT
#define LDS_WAIT() asm volatile("s_waitcnt lgkmcnt(0)" ::: "memory")
#define VM_WAIT() asm volatile("s_waitcnt vmcnt(0)" ::: "memory")
__device__ __forceinline__ unsigned long long rt() { return __builtin_amdgcn_s_memrealtime(); }
__device__ __forceinline__ unsigned f2bf(float f) { unsigned u = __builtin_bit_cast(unsigned, f); return (u + 0x7fffu + ((u >> 16) & 1u)) >> 16; }
__device__ __forceinline__ unsigned pk2(float lo, float hi) { return f2bf(lo) | (f2bf(hi) << 16); }
#define XB_TMO      128
#define XB_XCNT(j)  (256  + 64 * (j))
#define XB_XSUB(j)  (1280 + 64 * (j))
#define XB_XGEN(j)  (2304 + 64 * (j))
#define XB_TOP      3328
#define XB_TOPGEN   3392
#define XCD_BAR_WORDS 3456
#define XB_SPIN_CAP (1u << 18)

__device__ __forceinline__ unsigned xb_ld(unsigned* p)              { return __hip_atomic_load(p, __ATOMIC_RELAXED, __HIP_MEMORY_SCOPE_AGENT); }
__device__ __forceinline__ unsigned xb_add(unsigned* p, unsigned v) { return __hip_atomic_fetch_add(p, v, __ATOMIC_RELAXED, __HIP_MEMORY_SCOPE_AGENT); }
__device__ __forceinline__ unsigned xb_xcc_id() { return (unsigned)__builtin_amdgcn_s_getreg((3 << 11) | 20) & 0xFu; }
#define XB_SPIN(cond, bar) do { unsigned _sp = 0; while (cond) { __builtin_amdgcn_s_sleep(1); \
    if ((++_sp & 255u) == 0u) { if (xb_ld(&(bar)[XB_TMO])) break; if (_sp > XB_SPIN_CAP) { atomicAdd(&(bar)[XB_TMO], 1u); break; } } } } while (0)

struct XcdBarrier {
    unsigned* bar; unsigned x;
    volatile LAS unsigned* st;
};

__device__ __forceinline__ XcdBarrier xcd_barrier_post(unsigned* bar, volatile LAS unsigned* st) {
    XcdBarrier b; b.bar = bar; b.x = xb_xcc_id(); b.st = st;
    if (threadIdx.x == 0) (void)xb_add(&bar[XB_XCNT(b.x)], 1u);
    return b;
}
__device__ __forceinline__ void xcd_barrier_complete(unsigned* bar, unsigned x, unsigned& nloc, unsigned& nx) {
    const unsigned G = gridDim.x * gridDim.y * gridDim.z;
    unsigned sum, cnt, mine, sp = 0u;
    for (;;) {
        sum = 0u; cnt = 0u; mine = 0u;
#pragma unroll
        for (unsigned j = 0; j < 16; ++j) { const unsigned c = xb_ld(&bar[XB_XCNT(j)]); sum += c; cnt += (c > 0u) ? 1u : 0u; mine = (j == x) ? c : mine; }
        if (sum == G) break;
        __builtin_amdgcn_s_sleep(1);
        if ((++sp & 255u) == 0u) { if (xb_ld(&bar[XB_TMO])) break; if (sp > XB_SPIN_CAP) { atomicAdd(&bar[XB_TMO], 1u); break; } }
    }
    nloc = mine > 0u ? mine : 1u; nx = cnt > 0u ? cnt : 1u;
}

__device__ __forceinline__ void xcd_barrier(const XcdBarrier& b) {
    asm volatile("s_waitcnt vmcnt(0)" ::: "memory");
    __syncthreads();
    if (threadIdx.x == 0) {
        unsigned* bar = b.bar;
        __builtin_amdgcn_s_waitcnt(0);
        unsigned nloc = b.st[0], nx = b.st[1];
        if (nloc == 0u) { xcd_barrier_complete(bar, b.x, nloc, nx); b.st[0] = nloc; b.st[1] = nx; }
        const unsigned old = xb_add(&bar[XB_XSUB(b.x)], 1u);
        const unsigned gen = old / nloc;
        if (old + 1u == (gen + 1u) * nloc) {
            __builtin_amdgcn_fence(__ATOMIC_RELEASE, "agent");
            asm volatile("s_waitcnt vmcnt(0)" ::: "memory");
            const unsigned og = xb_add(&bar[XB_TOP], 1u);
            const unsigned tg = og / nx;
            if (og + 1u == (tg + 1u) * nx) xb_add(&bar[XB_TOPGEN], 1u);
            else XB_SPIN(xb_ld(&bar[XB_TOPGEN]) == tg, bar);
            __builtin_amdgcn_fence(__ATOMIC_ACQUIRE, "agent");
            xb_add(&bar[XB_XGEN(b.x)], 1u);
            asm volatile("s_waitcnt vmcnt(0)" ::: "memory");
        } else {
            XB_SPIN(xb_ld(&bar[XB_XGEN(b.x)]) == gen, bar);
            __builtin_amdgcn_fence(__ATOMIC_ACQUIRE, "agent");
            asm volatile("s_waitcnt vmcnt(0)" ::: "memory");
        }
    }
    __syncthreads();
}
#ifndef NBF
#define NBF 8
#endif
namespace fx {
constexpr int NWAVES = 8, NTHR = 512;
constexpr int SEQ = 4096, DM = 1024, TT = NBF * SEQ;
constexpr int NPROJ = 4096;
constexpr int MOE_TILES = TT * 2 / 256 + 32, MOE_ROWS = MOE_TILES * 256;
constexpr float LOG2E = 1.4426950408889634f;
constexpr float C2A = 0.10206207261596577f * LOG2E;
constexpr float C2B = 0.125f * LOG2E;
constexpr float EPS = 1e-6f;

constexpr size_t MiB = 1u << 20;
constexpr size_t al(size_t x) { return (x + 4095) & ~(size_t)4095; }
constexpr size_t WS_CTL = 0, CTL_ZERO_BYTES = 1 * MiB;
constexpr int CW_BAR = 4096;
constexpr size_t CTL_MOD = 65536;
constexpr size_t CTL_CNT = 524288;
constexpr size_t WS_WIN = 2 * MiB;
constexpr size_t WS_WUQ = 10 * MiB;
constexpr size_t WS_WKV = 10 * MiB + 512 * 1024;
constexpr size_t WS_WOAB = 11 * MiB;
constexpr size_t WS_WOUT = 13 * MiB;
constexpr size_t WS_WGU = 16 * MiB;
constexpr size_t WS_WD = 48 * MiB;
constexpr size_t WS_CS = 64 * MiB;
constexpr size_t WS_RT = WS_CS + al((size_t)TT * 16 * 8);
constexpr size_t RT_ARR = al((size_t)TT * 2 * 4);
constexpr size_t WS_RT_E = WS_RT, WS_RT_RANK = WS_RT + RT_ARR, WS_RT_W = WS_RT + 2 * RT_ARR, WS_RT_POS = WS_RT + 3 * RT_ARR;
constexpr size_t WS_RT_RINV = WS_RT + 4 * RT_ARR;
constexpr size_t WS_WROW = WS_RT + 5 * RT_ARR;
constexpr size_t WS_LIST = al(WS_WROW + (size_t)MOE_ROWS * 4);
constexpr size_t WS_MODP = al(WS_LIST + (size_t)MOE_ROWS * 4);
constexpr size_t WS_SSQ_Q = WS_MODP + 3 * MiB, WS_SSQ_KV = WS_SSQ_Q + (size_t)TT * 16;
constexpr size_t WS_SSQ_X = WS_SSQ_KV + (size_t)TT * 16;
constexpr size_t WS_ACT = al(WS_SSQ_X + (size_t)TT * 64);
constexpr size_t SZ_H = (size_t)TT * 1024 * 2;
constexpr size_t WS_H = WS_ACT;
constexpr size_t WS_QLAT = WS_H + SZ_H;
constexpr size_t WS_KVL = WS_QLAT + SZ_H / 4;
constexpr size_t WS_QB = WS_KVL + SZ_H / 4, WS_KB = WS_QB + SZ_H / 2, WS_VB = WS_KB + SZ_H / 2;
constexpr size_t WS_QA = WS_VB + SZ_H / 2;
constexpr size_t WS_KN = WS_QA + SZ_H * 3 / 4, WS_VA = WS_KN + SZ_H / 2;
constexpr size_t WS_KR = WS_VA + SZ_H / 2;
constexpr size_t WS_OAB = WS_KR + SZ_H / 32;
constexpr size_t WS_MERGED = WS_OAB + SZ_H;
constexpr size_t WS_END1 = WS_MERGED + SZ_H;
constexpr size_t WS_ELIST = WS_QLAT;
constexpr size_t WS_EWT = WS_ELIST + (size_t)32 * TT * 4;
constexpr size_t WS_HID = WS_EWT + (size_t)32 * TT * 4;
constexpr size_t WS_YB = WS_HID + (size_t)MOE_ROWS * 512;
constexpr size_t WS_END2 = WS_YB + (size_t)MOE_ROWS * 2048;
constexpr size_t WS_FAST_END = WS_END1 > WS_END2 ? WS_END1 : WS_END2;
static_assert(NBF != 8 || WS_FAST_END <= 512 * MiB, "workspace map exceeds 512 MiB");
static_assert(CTL_CNT + 32 * 256 <= CTL_ZERO_BYTES && (CW_BAR + 3 * 3456) * 4 <= (int)CTL_MOD, "ctl map");

constexpr int LDS_BYTES = 163840;
constexpr int RING_OFF = 0;
constexpr int P7S_OFF = 149504;
constexpr int LCTL_OFF = 159744;
static_assert(P7S_OFF + 8192 <= LCTL_OFF, "lds map");

struct Params {
    const float *x, *c; const int* pos;
    const float *w_ada, *b_ada, *g_mix, *w_in, *g_q, *w_uq, *g_kv, *w_uk, *w_uv, *rel, *w_oa, *w_ob, *w_out, *g_ffn, *w_rg, *b_rg, *w_re, *b_re, *w_gate, *w_up, *w_down, *g_final;
    float* out;
    unsigned char* ws;
    int ph_lo, ph_hi;
    int li, pad;
};
typedef const __attribute__((address_space(4))) Params* KP;
}
namespace fx {
using pg8::Unit; using pg8::bf16_t;
typedef float f32x2_t __attribute__((ext_vector_type(2)));
typedef __bf16 bf16x2_t __attribute__((ext_vector_type(2)));
typedef float f32x16 __attribute__((ext_vector_type(16)));
typedef short v4i16_t __attribute__((ext_vector_type(4)));
typedef unsigned u32x2 __attribute__((ext_vector_type(2)));
typedef unsigned u32x4 __attribute__((ext_vector_type(4)));

__device__ __forceinline__ unsigned cvtpk(float lo, float hi) { f32x2_t v = {lo, hi}; bf16x2_t b = __builtin_convertvector(v, bf16x2_t); return __builtin_bit_cast(unsigned, b); }
__device__ __forceinline__ float bf_lo(unsigned u) { return __builtin_bit_cast(float, u << 16); }
__device__ __forceinline__ float bf_hi(unsigned u) { return __builtin_bit_cast(float, u & 0xffff0000u); }
template <int CTRL, int ROWMASK> __device__ __forceinline__ float dpp_add(float v) {
    const int t = __builtin_amdgcn_update_dpp(0, __builtin_bit_cast(int, v), CTRL, ROWMASK, 0xF, false);
    return v + __builtin_bit_cast(float, t);
}
__device__ __forceinline__ float wave_sum(float v) {
    v = dpp_add<0xB1, 0xF>(v); v = dpp_add<0x4E, 0xF>(v); v = dpp_add<0x141, 0xF>(v); v = dpp_add<0x140, 0xF>(v);
    v = dpp_add<0x142, 0xA>(v); v = dpp_add<0x143, 0xC>(v);
    return __builtin_bit_cast(float, __builtin_amdgcn_readlane(__builtin_bit_cast(int, v), 63));
}
__device__ __forceinline__ float fsigmoid(float v) { return __builtin_amdgcn_rcpf(1.0f + __builtin_amdgcn_exp2f(-v * LOG2E)); }
__device__ __forceinline__ u32x4 pack8(const f32x4& a, const f32x4& b) { u32x4 w; w.x = cvtpk(a[0], a[1]); w.y = cvtpk(a[2], a[3]); w.z = cvtpk(b[0], b[1]); w.w = cvtpk(b[2], b[3]); return w; }

struct Frame {
    LAS unsigned char* lds;
    gu32* ctl;
    int tid, lane, wave, vcu, G;
};

struct EpiProj {
    static constexpr bool PERM = true, AFTER_DRAIN = false, MID = false;
    bf16_t *qlat, *kvl, *qb, *kb, *vb, *ga, *gb; float *ssq_q, *ssq_kv;
    __device__ __forceinline__ void operator()(const f32x4 (&acc)[2][2][4][2], const Unit& u, int wr, int wc, int fr, int fq) const {
        const int pn = u.pn;
        bf16_t* base; int ld, ct, mode = 0;
        float* ssqp = nullptr;
        if (pn == 0) { base = qlat; ld = 256; ct = 0; mode = 3; ssqp = ssq_q; }
        else if (pn == 1) { base = kvl; ld = 256; ct = 0; mode = 4; ssqp = ssq_kv; }
        else if (pn < 4) { base = qb; ld = 512; ct = (pn - 2) * 256; mode = 1; }
        else if (pn < 6) { base = kb; ld = 512; ct = (pn - 4) * 256; }
        else if (pn < 8) { base = vb; ld = 512; ct = (pn - 6) * 256; }
        else if (pn < 12) { base = ga; ld = 1024; ct = (pn - 8) * 256; mode = 2; }
        else { base = gb; ld = 1024; ct = (pn - 12) * 256; mode = 2; }
        const int row0 = u.pm * 256 + wr * 64 + fr, col0 = ct + wc * 32 + 8 * fq;
#pragma unroll
        for (int ai = 0; ai < 2; ++ai)
#pragma unroll
            for (int m = 0; m < 4; ++m) {
                const int row = row0 + ai * 128 + m * 16;
                bf16_t* rowp = base + (size_t)row * ld + col0;
                float ss0 = 0.f, ss1 = 0.f;
#pragma unroll
                for (int bj = 0; bj < 2; ++bj) {
                    f32x4 v0 = acc[ai][bj][m][0], v1 = acc[ai][bj][m][1];
                    if (mode == 1) { v0 = v0 * C2B; v1 = v1 * C2B; }
                    if (mode == 2) {
#pragma unroll
                        for (int e = 0; e < 4; ++e) { v0[e] = fsigmoid(v0[e]); v1[e] = fsigmoid(v1[e]); } }
                    const float s = (v0[0] * v0[0] + v0[1] * v0[1]) + (v0[2] * v0[2] + v0[3] * v0[3]) + (v1[0] * v1[0] + v1[1] * v1[1]) + (v1[2] * v1[2] + v1[3] * v1[3]);
                    if (bj == 0) ss0 = s; else ss1 = s;
                    *(u32x4*)(rowp + bj * 128) = pack8(v0, v1);
                }
                if (mode >= 3) {
                    float s = (mode == 3) ? ss0 + ss1 : ss0;
                    s += __shfl_xor(s, 16); s += __shfl_xor(s, 32);
                    if (fq == 0) ssqp[row * 4 + wc] = s;
                }
            }
    }
};
struct EpiQA {
    static constexpr bool PERM = true, AFTER_DRAIN = false, MID = false;
    bf16_t* qa; const float* ssq_q; const float* cs;
    __device__ __forceinline__ void operator()(const f32x4 (&acc)[2][2][4][2], const Unit& u, int wr, int wc, int fr, int fq) const {
        const int pn = u.pn, row0 = u.pm * 256 + wr * 64 + fr, col0 = pn * 256 + wc * 32 + 8 * fq;
        f32x4 sp[2][4];
#pragma unroll
        for (int ai = 0; ai < 2; ++ai)
#pragma unroll
            for (int m = 0; m < 4; ++m) sp[ai][m] = *(const f32x4*)(ssq_q + (size_t)(row0 + ai * 128 + m * 16) * 4);
#pragma unroll
        for (int ah = 0; ah < 4; ++ah) {
            const int ai = ah >> 1; f32x4 cq[2][4];
            if (pn == 2) {
#pragma unroll
                for (int mm = 0; mm < 2; ++mm) { const f32x4* csr = (const f32x4*)(cs + (size_t)(row0 + ai * 128 + ((ah & 1) * 2 + mm) * 16) * 32 + 16 * (fq & 1));
#pragma unroll
                    for (int j = 0; j < 4; ++j) cq[mm][j] = csr[j]; } }
#pragma unroll
            for (int mm = 0; mm < 2; ++mm) {
                const int m = (ah & 1) * 2 + mm, row = row0 + ai * 128 + m * 16;
                const float sc = C2A / sqrtf(((sp[ai][m][0] + sp[ai][m][1]) + (sp[ai][m][2] + sp[ai][m][3])) * (1.f / 256.f) + EPS);
                bf16_t* rowp = qa + (size_t)row * 768 + col0;
                if (pn < 2) {
#pragma unroll
                    for (int bj = 0; bj < 2; ++bj) *(u32x4*)(rowp + bj * 128) = pack8(acc[ai][bj][m][0] * sc, acc[ai][bj][m][1] * sc);
                } else {
                    const float cc[8] = {cq[mm][0][0], cq[mm][0][2], cq[mm][1][0], cq[mm][1][2], cq[mm][2][0], cq[mm][2][2], cq[mm][3][0], cq[mm][3][2]};
                    const float sn[8] = {cq[mm][0][1], cq[mm][0][3], cq[mm][1][1], cq[mm][1][3], cq[mm][2][1], cq[mm][2][3], cq[mm][3][1], cq[mm][3][3]};
                    const float sgn = (fq < 2) ? -1.f : 1.f;
#pragma unroll
                    for (int bj = 0; bj < 2; ++bj) {
                        f32x4 o[2];
#pragma unroll
                        for (int n = 0; n < 2; ++n)
#pragma unroll
                            for (int e = 0; e < 4; ++e) { const float v = acc[ai][bj][m][n][e] * sc; const float p = __shfl_xor(v, 32); o[n][e] = v * cc[4 * n + e] + sgn * p * sn[4 * n + e]; }
                        *(u32x4*)(rowp + bj * 128) = pack8(o[0], o[1]);
                    }
                }
            }
        }
    }
};
struct EpiKV {
    static constexpr bool PERM = true, AFTER_DRAIN = false, MID = false;
    bf16_t *kn, *va; const float* ssq_kv;
    __device__ __forceinline__ void operator()(const f32x4 (&acc)[2][2][4][2], const Unit& u, int wr, int wc, int fr, int fq) const {
        const int pn = u.pn, row0 = u.pm * 256 + wr * 64 + fr, col0 = (pn & 1) * 256 + wc * 32 + 8 * fq;
        bf16_t* base = pn < 2 ? kn : va;
        f32x4 spv[2][4];
#pragma unroll
        for (int ai = 0; ai < 2; ++ai)
#pragma unroll
            for (int m = 0; m < 4; ++m) spv[ai][m] = *(const f32x4*)(ssq_kv + (size_t)(row0 + ai * 128 + m * 16) * 4);
#pragma unroll
        for (int ai = 0; ai < 2; ++ai)
#pragma unroll
            for (int m = 0; m < 4; ++m) {
                const int row = row0 + ai * 128 + m * 16;
                const f32x4 sp = spv[ai][m]; const float sc = 1.0f / sqrtf(((sp[0] + sp[1]) + (sp[2] + sp[3])) * (1.f / 128.f) + EPS);
                bf16_t* rowp = base + (size_t)row * 512 + col0;
#pragma unroll
                for (int bj = 0; bj < 2; ++bj) *(u32x4*)(rowp + bj * 128) = pack8(acc[ai][bj][m][0] * sc, acc[ai][bj][m][1] * sc);
            }
    }
};
struct EpiMerge {
    static constexpr bool PERM = true, AFTER_DRAIN = false, MID = true;
    bf16_t* merged; const bf16_t *ga, *gb;
    __device__ __forceinline__ bool is_mid(const Unit& u) const { return u.pn < 4; }
    __device__ __forceinline__ void mid(f32x4 (&acc)[2][2][4][2], const Unit& u, int wr, int wc, int fr, int fq) const {
        const int row0 = u.pm * 256 + wr * 64 + fr, col0 = u.pn * 256 + wc * 32 + 8 * fq;
#pragma unroll
        for (int ai = 0; ai < 2; ++ai) {
            u32x4 av[4][2], bv[4][2];
#pragma unroll
            for (int m = 0; m < 4; ++m)
#pragma unroll
                for (int bj = 0; bj < 2; ++bj) { const size_t off = (size_t)(row0 + ai * 128 + m * 16) * 1024 + col0 + bj * 128; av[m][bj] = *(const u32x4*)(ga + off); bv[m][bj] = *(const u32x4*)(gb + off); }
#pragma unroll
            for (int m = 0; m < 4; ++m)
#pragma unroll
                for (int bj = 0; bj < 2; ++bj) {
                    const u32x4 a = av[m][bj], c = bv[m][bj];
                    const float sa[8] = {bf_lo(a.x), bf_hi(a.x), bf_lo(a.y), bf_hi(a.y), bf_lo(a.z), bf_hi(a.z), bf_lo(a.w), bf_hi(a.w)};
                    const float sb[8] = {bf_lo(c.x), bf_hi(c.x), bf_lo(c.y), bf_hi(c.y), bf_lo(c.z), bf_hi(c.z), bf_lo(c.w), bf_hi(c.w)};
#pragma unroll
                    for (int e = 0; e < 4; ++e) { acc[ai][bj][m][0][e] *= sa[e] * __builtin_amdgcn_rcpf(fmaxf(sb[e], 1e-12f)); acc[ai][bj][m][1][e] *= sa[4 + e] * __builtin_amdgcn_rcpf(fmaxf(sb[4 + e], 1e-12f)); }
                }
        }
    }
    __device__ __forceinline__ void operator()(const f32x4 (&acc)[2][2][4][2], const Unit& u, int wr, int wc, int fr, int fq) const {
        const int pn = u.pn & 3, pm = u.pm - TT / 256;
        const int row0 = pm * 256 + wr * 64 + fr, col0 = pn * 256 + wc * 32 + 8 * fq;
#pragma unroll
        for (int ai = 0; ai < 2; ++ai) {
            u32x4 bv[4][2];
#pragma unroll
            for (int m = 0; m < 4; ++m)
#pragma unroll
                for (int bj = 0; bj < 2; ++bj) bv[m][bj] = *(const u32x4*)(gb + (size_t)(row0 + ai * 128 + m * 16) * 1024 + col0 + bj * 128);
#pragma unroll
            for (int m = 0; m < 4; ++m)
#pragma unroll
                for (int bj = 0; bj < 2; ++bj) {
                    const u32x4 c = bv[m][bj];
                    const float sb[8] = {bf_lo(c.x), bf_hi(c.x), bf_lo(c.y), bf_hi(c.y), bf_lo(c.z), bf_hi(c.z), bf_lo(c.w), bf_hi(c.w)};
                    f32x4 v0 = acc[ai][bj][m][0], v1 = acc[ai][bj][m][1];
#pragma unroll
                    for (int e = 0; e < 4; ++e) { v0[e] *= fmaxf(sb[e], 1e-12f); v1[e] *= fmaxf(sb[4 + e], 1e-12f); }
                    *(u32x4*)(merged + (size_t)(row0 + ai * 128 + m * 16) * 1024 + col0 + bj * 128) = pack8(v0, v1);
                }
        }
    }
};
struct EpiResid {
    static constexpr bool PERM = false, AFTER_DRAIN = false, MID = false;
    const float* x; float* x1; const float* mod; float* ssqx;
    __device__ __forceinline__ void operator()(const f32x4 (&acc)[2][2][4][2], const Unit& u, int wr, int wc, int fr, int fq) const {
        const int row0 = u.pm * 256 + wr * 64 + fr, col0 = u.pn * 256 + wc * 32 + 4 * fq;
        const float* gt = mod + (size_t)(u.pm / 16) * 6144 + 2048;
        f32x4 gv[2][2];
#pragma unroll
        for (int bj = 0; bj < 2; ++bj)
#pragma unroll
            for (int n = 0; n < 2; ++n) gv[bj][n] = *(const f32x4*)(gt + col0 + bj * 128 + n * 16);
#pragma unroll
        for (int ai = 0; ai < 2; ++ai) {
            f32x4 xv[4][2][2];
#pragma unroll
            for (int m = 0; m < 4; ++m) { const size_t off = (size_t)(row0 + ai * 128 + m * 16) * 1024 + col0;
#pragma unroll
                for (int bj = 0; bj < 2; ++bj)
#pragma unroll
                    for (int n = 0; n < 2; ++n) xv[m][bj][n] = *(const f32x4*)(x + off + bj * 128 + n * 16); }
#pragma unroll
            for (int m = 0; m < 4; ++m) { const size_t off = (size_t)(row0 + ai * 128 + m * 16) * 1024 + col0;
#pragma unroll
                for (int bj = 0; bj < 2; ++bj)
#pragma unroll
                    for (int n = 0; n < 2; ++n) { const f32x4 r = xv[m][bj][n] + gv[bj][n] * acc[ai][bj][m][n]; *(f32x4*)(x1 + off + bj * 128 + n * 16) = r; xv[m][bj][n] = r; } }
#pragma unroll
            for (int m = 0; m < 4; ++m) { float s = 0.f;
#pragma unroll
                for (int bj = 0; bj < 2; ++bj)
#pragma unroll
                    for (int n = 0; n < 2; ++n) { const f32x4 r = xv[m][bj][n]; s += (r[0] * r[0] + r[1] * r[1]) + (r[2] * r[2] + r[3] * r[3]); }
                s += __shfl_xor(s, 16); s += __shfl_xor(s, 32);
                if (fq == 0) ssqx[(size_t)(row0 + ai * 128 + m * 16) * 16 + u.pn * 4 + wc] = s; }
        }
    }
};
struct EpiGU {
    static constexpr bool PERM = true, AFTER_DRAIN = false, MID = false;
    bf16_t* hid; const float* ewt; const LAS int* tab; const LAS int* toff;
    __device__ __forceinline__ void operator()(const f32x4 (&acc)[2][2][4][2], const Unit& u, int wr, int wc, int fr, int fq) const {
        const int row0 = u.pm * 256 + wr * 64 + fr, col0 = (u.pn & 1) * 128 + wc * 32 + 8 * fq;
        float wv[2][4];
        const int e_ = __builtin_amdgcn_readfirstlane(tab[1 + u.pm]), base_ = __builtin_amdgcn_readfirstlane(toff[e_]) * 256, cnt_ = __builtin_amdgcn_readfirstlane(toff[40 + e_]);
#pragma unroll
        for (int ai = 0; ai < 2; ++ai)
#pragma unroll
            for (int m = 0; m < 4; ++m) { const int idx = row0 + ai * 128 + m * 16 - base_; wv[ai][m] = idx < cnt_ ? ewt[(size_t)e_ * TT + idx] : 0.f; }
#pragma unroll
        for (int ai = 0; ai < 2; ++ai)
#pragma unroll
            for (int m = 0; m < 4; ++m) {
                const int row = row0 + ai * 128 + m * 16; const float w = wv[ai][m];
                f32x4 o[2];
#pragma unroll
                for (int n = 0; n < 2; ++n)
#pragma unroll
                    for (int e = 0; e < 4; ++e) { const float a = acc[ai][0][m][n][e], uu = acc[ai][1][m][n][e]; o[n][e] = a * fsigmoid(a) * uu * w; }
                *(u32x4*)(hid + (size_t)row * 256 + col0) = pack8(o[0], o[1]);
            }
    }
};
struct EpiDown {
    static constexpr bool PERM = true, AFTER_DRAIN = false, MID = false;
    bf16_t* yb;
    __device__ __forceinline__ void operator()(const f32x4 (&acc)[2][2][4][2], const Unit& u, int wr, int wc, int fr, int fq) const {
        const int row0 = u.pm * 256 + wr * 64 + fr, col0 = (u.pn & 3) * 256 + wc * 32 + 8 * fq;
#pragma unroll
        for (int ai = 0; ai < 2; ++ai)
#pragma unroll
            for (int m = 0; m < 4; ++m) { bf16_t* rowp = yb + (size_t)(row0 + ai * 128 + m * 16) * 1024 + col0;
#pragma unroll
                for (int bj = 0; bj < 2; ++bj) *(u32x4*)(rowp + bj * 128) = pack8(acc[ai][bj][m][0], acc[ai][bj][m][1]); }
    }
};

struct PairOrder {
    static constexpr bool GATHER = false; __device__ __forceinline__ unsigned a_row_off(int) const { return 0u; }
    pg8::StaticOrder so;
    __device__ void init(int G, int c) { so.init(TT, 1024, G, c); }
    __device__ bool next(int i, Unit& u) const { if (!so.next(i >> 1, u)) return false; if (i & 1) { u.pm += TT / 256; u.pn += 4; } return true; }
    __device__ __forceinline__ void a_ready(const Unit&) const {}
    __device__ __forceinline__ void done(const Unit&) const {}
};
template <bool GATHER_> struct MoeOrderT {
    static constexpr bool GATHER = GATHER_; const int* elist; const LAS int* toff;
    __device__ __forceinline__ unsigned a_row_off(int r) const {
        const int e = __builtin_amdgcn_readfirstlane(tab[1 + (r >> 8)]), idx = r - __builtin_amdgcn_readfirstlane(toff[e]) * 256, cnt = __builtin_amdgcn_readfirstlane(toff[40 + e]);
        const int tok = elist[(size_t)e * TT + (idx < TT ? idx : TT - 1)]; return (unsigned)(idx < cnt ? tok : 0) * 2048u; }
    const LAS int* tab; int nct, G, c;
    __device__ bool next(int i, Unit& u) const {
        const int nrt = __builtin_amdgcn_readfirstlane(tab[0]); const long L = (long)i * G + c; if (L >= (long)nrt * nct) return false;
        const int rt = (int)(L / nct), ct = (int)(L % nct); u.pm = rt; u.pn = __builtin_amdgcn_readfirstlane(tab[1 + rt]) * nct + ct; return true;
    }
    __device__ __forceinline__ void a_ready(const Unit&) const {}
    __device__ __forceinline__ void done(const Unit&) const {}
};
typedef MoeOrderT<false> MoeOrder;
}
namespace fx {
typedef short bf16x8 __attribute__((ext_vector_type(8)));
__device__ __forceinline__ void tr_item(const float* W, int ldw, int k0, int n0, bf16_t* WT, int ldt, int drow0, const float* kscale, LAS float* scr, int lane) {
    float tv[32];
#pragma unroll
    for (int i = 0; i < 32; ++i) { const int kk = 2 * i + (lane >> 5); tv[i] = W[(size_t)(k0 + kk) * ldw + n0 + (lane & 31)]; }
#pragma unroll
    for (int i = 0; i < 32; ++i) { const int kk = 2 * i + (lane >> 5); float v = tv[i]; if (kscale) v *= kscale[k0 + kk]; scr[kk * 33 + (lane & 31)] = v; }
    LDS_WAIT(); asm volatile("" ::: "memory");
    const int c = lane & 7;
#pragma unroll
    for (int j = 0; j < 4; ++j) { const int n = (lane >> 3) + 8 * j; const LAS float* s = scr + (8 * c) * 33 + n;
        u32x4 o; o.x = cvtpk(s[0 * 33], s[1 * 33]); o.y = cvtpk(s[2 * 33], s[3 * 33]); o.z = cvtpk(s[4 * 33], s[5 * 33]); o.w = cvtpk(s[6 * 33], s[7 * 33]);
        *(u32x4*)(WT + (size_t)(drow0 + n) * ldt + k0 + 8 * c) = o; }
    LDS_WAIT(); asm volatile("" ::: "memory");
}
__device__ __forceinline__ void p0_prologue(KP P, Frame& F) {
    unsigned char* ws = P->ws;
    LAS float* scr = (LAS float*)(F.lds + RING_OFF + F.wave * 16384);
    const int gw = F.vcu * NWAVES + F.wave, NGW = F.G * NWAVES, lane = F.lane;
    bf16_t* WinT = (bf16_t*)(ws + WS_WIN); bf16_t* WuqT = (bf16_t*)(ws + WS_WUQ); bf16_t* WkvT = (bf16_t*)(ws + WS_WKV);
    bf16_t* WoabT = (bf16_t*)(ws + WS_WOAB); bf16_t* WoutT = (bf16_t*)(ws + WS_WOUT); bf16_t* WguT = (bf16_t*)(ws + WS_WGU); bf16_t* WdT = (bf16_t*)(ws + WS_WD);
    constexpr int I_IN = 16 * 125, I_UQ = 4 * 24, I_UK = 2 * 16, I_OA = 8 * 32, I_OUT = 16 * 32, I_G = 16 * 8, I_D = 4 * 32, I_E = 2 * I_G + I_D;
    constexpr int NITEMS = I_IN + I_UQ + 2 * I_UK + 2 * I_OA + I_OUT + 32 * I_E;
    for (int it = gw; it < NITEMS; it += NGW) {
        int r = it;
        if (r < I_IN) { const int kb = r / 125, nb = r % 125, n0 = nb * 32; tr_item(P->w_in, 4000, kb * 64, n0, WinT, 1024, n0 < 416 ? n0 : n0 + 96, nullptr, scr, lane); continue; } r -= I_IN;
        if (r < I_UQ) { const int kb = r / 24, nb = r % 24, n0 = nb * 32, h = n0 / 96, j = (n0 % 96) / 32; tr_item(P->w_uq, 768, kb * 64, n0, WuqT, 256, j < 2 ? h * 64 + 32 * j : 512 + 32 * h, P->g_q, scr, lane); continue; } r -= I_UQ;
        if (r < I_UK) { const int kb = r / 16, nb = r % 16; tr_item(P->w_uk, 512, kb * 64, nb * 32, WkvT, 256, nb * 32, P->g_kv, scr, lane); continue; } r -= I_UK;
        if (r < I_UK) { const int kb = r / 16, nb = r % 16; tr_item(P->w_uv, 512, kb * 64, nb * 32, WkvT, 256, 512 + nb * 32, P->g_kv, scr, lane); continue; } r -= I_UK;
        if (r < I_OA) { const int kb = r / 32, nb = r % 32; tr_item(P->w_oa, 1024, kb * 64, nb * 32, WoabT, 512, nb * 32, nullptr, scr, lane); continue; } r -= I_OA;
        if (r < I_OA) { const int kb = r / 32, nb = r % 32; tr_item(P->w_ob, 1024, kb * 64, nb * 32, WoabT, 512, 1024 + nb * 32, nullptr, scr, lane); continue; } r -= I_OA;
        if (r < I_OUT) { const int kb = r / 32, nb = r % 32; tr_item(P->w_out, 1024, kb * 64, nb * 32, WoutT, 1024, nb * 32, nullptr, scr, lane); continue; } r -= I_OUT;
        const int e = r / I_E; r -= e * I_E;
        if (r < I_G) { const int kb = r / 8, nb = r % 8, n0 = nb * 32; tr_item(P->w_gate + (size_t)e * 262144, 256, kb * 64, n0, WguT, 1024, e * 512 + (n0 >> 7) * 256 + (n0 & 127), nullptr, scr, lane); continue; } r -= I_G;
        if (r < I_G) { const int kb = r / 8, nb = r % 8, n0 = nb * 32; tr_item(P->w_up + (size_t)e * 262144, 256, kb * 64, n0, WguT, 1024, e * 512 + (n0 >> 7) * 256 + 128 + (n0 & 127), nullptr, scr, lane); continue; } r -= I_G;
        { const int kb = r / 32, nb = r % 32; tr_item(P->w_down + (size_t)e * 262144, 1024, kb * 64, nb * 32, WdT, 256, e * 1024 + nb * 32, nullptr, scr, lane); }
    }
    const int gt = gw * 64 + lane, NGT = NGW * 64; const u32x4 z4 = {0u, 0u, 0u, 0u};
    for (int i = gt; i < 12288; i += NGT) *(u32x4*)(WinT + (size_t)416 * 1024 + (size_t)i * 8) = z4;
    for (int i = gt; i < 16384; i += NGT) *(u32x4*)(WkvT + (size_t)(i >> 4) * 256 + 128 + (i & 15) * 8) = z4;
    float* modp = (float*)(ws + WS_MODP);
    for (int it = gw; it < 96 * 16; it += NGW) {
        const int cg = it % 96, ks = it / 96, n = cg * 64 + lane, k0 = ks * 64;
#pragma unroll
        for (int b = 0; b < 8; ++b) { const float cv = P->c[b * 1024 + k0 + lane]; scr[b * 64 + lane] = cv / (1.f + __expf(-cv)); }
        LDS_WAIT(); asm volatile("" ::: "memory");
        float a[8];
#pragma unroll
        for (int b = 0; b < 8; ++b) a[b] = 0.f;
#pragma unroll 16
        for (int k = 0; k < 64; ++k) { const float w = P->w_ada[(size_t)(k0 + k) * 6144 + n];
#pragma unroll
            for (int b = 0; b < 8; ++b) a[b] += scr[b * 64 + k] * w; }
        const float bias = (ks == 0) ? P->b_ada[n] : 0.f;
#pragma unroll
        for (int b = 0; b < 8; ++b) modp[((size_t)ks * 8 + b) * 6144 + n] = a[b] + bias;
        LDS_WAIT(); asm volatile("" ::: "memory");
    }
    f32x2_t* cs = (f32x2_t*)(ws + WS_CS);
    for (int i = gt; i < TT * 16; i += NGT) { const int t = i >> 4, j = i & 15; const float ang = (float)P->pos[t] * powf(10000.0f, -(float)j * (1.f / 16.f)); f32x2_t v; v.x = cosf(ang); v.y = sinf(ang); cs[i] = v; }
}
__device__ __forceinline__ void p1_norm(KP P, Frame& F) {
    const int lane = F.lane, tid = F.tid, wid = F.wave;
    const float* modp = (const float*)(P->ws + WS_MODP); float* modf = (float*)(P->ws + CTL_MOD); bf16_t* H = (bf16_t*)(P->ws + WS_H);
    LAS float* modl = (LAS float*)(F.lds + RING_OFF);
    const int RPW = (TT + F.G - 1) / F.G, row_lo = F.vcu * RPW, b = row_lo / SEQ, wpb = SEQ / RPW, slice = 6144 / wpb, s0 = (F.vcu % wpb) * slice;
    for (int i = tid; i < 2048; i += NTHR) { float a = 0.f;
#pragma unroll
        for (int ks = 0; ks < 16; ++ks) a += modp[((size_t)ks * 8 + b) * 6144 + i];
        modl[i] = a; }
    for (int i = tid; i < slice; i += NTHR) { float a = 0.f;
#pragma unroll
        for (int ks = 0; ks < 16; ++ks) a += modp[((size_t)ks * 8 + b) * 6144 + s0 + i];
        modf[(size_t)b * 6144 + s0 + i] = a; }
    __syncthreads();
    const int rpwave = RPW / NWAVES;
    for (int it = 0; it < rpwave; it += 2) {
        const int m0 = row_lo + wid * rpwave + it;
        f32x4 v[2][4]; float ss[2];
#pragma unroll
        for (int rr = 0; rr < 2; ++rr) { const f32x4* xr = (const f32x4*)(P->x + (size_t)(m0 + rr) * 1024) + lane;
#pragma unroll
            for (int j = 0; j < 4; ++j) v[rr][j] = xr[64 * j]; }
#pragma unroll
        for (int rr = 0; rr < 2; ++rr) { float s = 0.f;
#pragma unroll
            for (int j = 0; j < 4; ++j) s += (v[rr][j][0] * v[rr][j][0] + v[rr][j][1] * v[rr][j][1]) + (v[rr][j][2] * v[rr][j][2] + v[rr][j][3] * v[rr][j][3]);
            ss[rr] = wave_sum(s); }
#pragma unroll
        for (int rr = 0; rr < 2; ++rr) {
            const float inv = 1.0f / sqrtf(ss[rr] * (1.f / 1024.f) + EPS);
            u32x2* o8 = (u32x2*)(H + (size_t)(m0 + rr) * 1024) + lane;
#pragma unroll
            for (int j = 0; j < 4; ++j) { const int col = 4 * lane + 256 * j;
                const f32x4 g = *(const f32x4*)(P->g_mix + col), s1 = *(const LAS f32x4*)(modl + 1024 + col), h1 = *(const LAS f32x4*)(modl + col);
                f32x4 y;
#pragma unroll
                for (int e = 0; e < 4; ++e) y[e] = v[rr][j][e] * inv * g[e] * (1.f + s1[e]) + h1[e];
                u32x2 w; w.x = cvtpk(y[0], y[1]); w.y = cvtpk(y[2], y[3]); o8[64 * j] = w; }
        }
    }
    __syncthreads();
}
__device__ __forceinline__ void p3_krope(KP P, Frame& F) {
    const int gt = (F.vcu * NWAVES + F.wave) * 64 + F.lane, NGT = F.G * NWAVES * 64;
    const bf16_t* kvl = (const bf16_t*)(P->ws + WS_KVL); bf16_t* kr = (bf16_t*)(P->ws + WS_KR); const f32x2_t* cs = (const f32x2_t*)(P->ws + WS_CS);
    for (int i = gt; i < TT * 16; i += NGT) { const int t = i >> 4, j = i & 15;
        const float x1 = bf_lo((unsigned)kvl[(size_t)t * 256 + 128 + j]), x2 = bf_lo((unsigned)kvl[(size_t)t * 256 + 144 + j]); const f32x2_t c = cs[i];
        kr[(size_t)t * 32 + j] = (bf16_t)(cvtpk(x1 * c.x - x2 * c.y, 0.f) & 0xffffu); kr[(size_t)t * 32 + 16 + j] = (bf16_t)(cvtpk(x2 * c.x + x1 * c.y, 0.f) & 0xffffu); }
}
__device__ __forceinline__ int crow(int r, int hi) { return (r & 3) + 8 * (r >> 2) + 4 * hi; }
__device__ __forceinline__ void att_glds16(const void* gsrc, unsigned lds_dst) { unsigned keep;
    asm volatile("s_mov_b32 %0, m0\n\ts_mov_b32 m0, %2\n\ts_nop 0\n\tglobal_load_lds_dwordx4 %1, off\n\ts_mov_b32 m0, %0" : "=&s"(keep) : "v"(gsrc), "s"(lds_dst) : "memory"); }
__device__ __forceinline__ float att_max3(float a, float b, float c) { return __builtin_fmaxf(__builtin_fmaxf(a, b), c); }
__device__ __forceinline__ float att_fadd(float a, float b) { float r; asm("v_add_f32_e32 %0, %1, %2" : "=v"(r) : "v"(a), "v"(b)); return r; }
__device__ __forceinline__ void att_wait(int n) {
    if (n >= 6) asm volatile("s_waitcnt vmcnt(6)" ::: "memory"); else if (n == 4) asm volatile("s_waitcnt vmcnt(4)" ::: "memory");
    else if (n == 3) asm volatile("s_waitcnt vmcnt(3)" ::: "memory"); else if (n == 2) asm volatile("s_waitcnt vmcnt(2)" ::: "memory"); else asm volatile("s_waitcnt vmcnt(0)" ::: "memory");
}
template <bool MLA, int MODE = 0>
__device__ __forceinline__ void attn_unit(Frame& F, const bf16_t* Q1, int ldq1, const bf16_t* Q2, int ldq2, const bf16_t* K1, int ldk1, const bf16_t* K2, int ldk2,
                                          const bf16_t* V, int ldv, bf16_t* O, int ldo, int qb, const float* relh) {
    constexpr int NS = MLA ? 6 : 4, K2OFF = 8192, VOFF = MLA ? 12288 : 8192, SLOT = VOFF + 8192, NSLOT = 4, BT_OFF = NSLOT * SLOT;
    LAS unsigned char* lds = F.lds + RING_OFF;
    LAS float* btab = (LAS float*)(lds + BT_OFF);
    const int tid = F.tid, lane = F.lane, wid = F.wave, r32 = lane & 31, hh = lane >> 5;
    const int q0 = qb * 256 + wid * 32, qc = q0 >> 6;
    const int kt_lo = MLA ? 0 : (4 * qb - 8 < 0 ? 0 : 4 * qb - 8), kt_hi = 4 * qb + 3;
    const int my_lo = MLA ? 0 : (qc - 8 < 0 ? 0 : qc - 8), my_hi = qc;
    const bf16_t* k1src = K1 + (size_t)(8 * wid + (lane >> 3)) * ldk1 + (((lane & 7) ^ ((4 * wid + (lane >> 4)) & 7)) << 3);
    const bf16_t* vsrc = V + (size_t)(16 * (wid & 3) + (lane >> 2)) * ldv + (wid >> 2) * 32 + ((lane & 3) << 3);
    const bf16_t* k2src = MLA ? K2 + (size_t)(16 * (wid & 3) + (lane >> 2)) * ldk2 + (((lane & 3) ^ ((lane >> 4) & 3)) << 3) : nullptr;
    const int npt = (MLA && wid < 4) ? 3 : 2;
    const unsigned lds_u = (unsigned)(unsigned long long)lds;
#define ATT_ISSUE(kt) do { const unsigned sl_ = (unsigned)__builtin_amdgcn_readfirstlane((int)(lds_u + ((kt) & 3) * SLOT + wid * 1024)); \
        att_glds16(k1src + (size_t)(kt) * 64 * ldk1, sl_); \
        att_glds16(vsrc + (size_t)(kt) * 64 * ldv, sl_ + VOFF); \
        if (MLA && wid < 4) att_glds16(k2src + (size_t)(kt) * 64 * ldk2, sl_ + K2OFF); } while (0)
    if (!MLA) { for (int i = tid; i < 640; i += NTHR) btab[i] = relh[i < 512 ? i : 512] * LOG2E; __syncthreads(); }
    ATT_ISSUE(kt_lo); if (kt_lo + 1 <= kt_hi) ATT_ISSUE(kt_lo + 1); if (kt_lo + 2 <= kt_hi) ATT_ISSUE(kt_lo + 2);
    bf16x8 qf[NS];
    { const bf16_t* qrow = Q1 + (size_t)(q0 + r32) * ldq1 + 8 * hh;
#pragma unroll
      for (int s = 0; s < 4; ++s) qf[s] = *(const bf16x8*)(qrow + 16 * s);
      if (MLA) { const bf16_t* qrow2 = Q2 + (size_t)(q0 + r32) * ldq2 + 8 * hh;
#pragma unroll
          for (int s = 4; s < NS; ++s) qf[s] = *(const bf16x8*)(qrow2 + 16 * (s - 4)); } }
#pragma unroll
    for (int s = 0; s < NS; ++s) asm volatile("" : "+v"(qf[s]));
    float mref = 0.f, lrun = 0.f; bool first = true; f32x16 o0, o1, negm;
#pragma unroll
    for (int r = 0; r < 16; ++r) { o0[r] = 0.f; o1[r] = 0.f; negm[r] = 0.f; }
    int koff[NS];
#pragma unroll
    for (int s = 0; s < 4; ++s) koff[s] = r32 * 128 + (((2 * s + hh) ^ ((r32 >> 1) & 7)) << 4);
    if (MLA) {
#pragma unroll
        for (int s = 4; s < NS; ++s) koff[s] = K2OFF + r32 * 64 + (((2 * (s - 4) + hh) ^ ((r32 >> 2) & 3)) << 4); }
    const int vrd = VOFF + (4 * hh + ((lane & 15) >> 2)) * 64 + ((lane >> 4) & 1) * 32 + (lane & 3) * 8;
    { const int nout = (kt_hi - kt_lo < 2 ? kt_hi - kt_lo : 2); att_wait(nout * npt); }
    __builtin_amdgcn_s_barrier(); asm volatile("" ::: "memory");
    if (wid >= 4) __builtin_amdgcn_s_setprio(1);
    for (int kt = kt_lo; kt <= kt_hi; ++kt) {
        if (kt + 3 <= kt_hi) ATT_ISSUE(kt + 3);
        if (kt >= my_lo && kt <= my_hi) {
            const LAS unsigned char* Sb = lds + (kt & 3) * SLOT;
            f32x16 p0, p1;
            bf16x8 ka[NS], kb[NS];
#pragma unroll
            for (int s = 0; s < NS; ++s) { ka[s] = *(const LAS bf16x8*)(Sb + koff[s]); kb[s] = *(const LAS bf16x8*)(Sb + koff[s] + (s < 4 ? 4096 : 2048)); }
            __builtin_amdgcn_sched_barrier(0);
#pragma unroll
            for (int s = 0; s < NS; ++s) {
                if (MODE & 2) { asm volatile("" :: "v"(ka[s]), "v"(kb[s])); } else {
                if (s == 0) { p0 = __builtin_amdgcn_mfma_f32_32x32x16_bf16(ka[0], qf[0], negm, 0, 0, 0); p1 = __builtin_amdgcn_mfma_f32_32x32x16_bf16(kb[0], qf[0], negm, 0, 0, 0); }
                else { p0 = __builtin_amdgcn_mfma_f32_32x32x16_bf16(ka[s], qf[s], p0, 0, 0, 0); p1 = __builtin_amdgcn_mfma_f32_32x32x16_bf16(kb[s], qf[s], p1, 0, 0, 0); } }
            }
            bf16x8 vfr[4][2];
#pragma unroll
            for (int s = 0; s < 4; ++s)
#pragma unroll
                for (int ds = 0; ds < 2; ++ds) {
                    const LAS unsigned char* vb = Sb + vrd + ds * 4096 + s * 1024;
                    const v4i16_t lo = __builtin_amdgcn_ds_read_tr16_b64_v4i16((LAS v4i16_t*)vb);
                    const v4i16_t hi = __builtin_amdgcn_ds_read_tr16_b64_v4i16((LAS v4i16_t*)(vb + 512));
                    vfr[s][ds] = (bf16x8){lo[0], lo[1], lo[2], lo[3], hi[0], hi[1], hi[2], hi[3]}; }
            __builtin_amdgcn_sched_barrier(0);
            if (!MLA) {
                if (qc - kt >= 5) { const float bc = btab[512];
#pragma unroll
                    for (int r = 0; r < 16; ++r) { p0[r] += bc; p1[r] += bc; } }
                else {
                    const LAS float* bp = btab + ((q0 + r32) - kt * 64 + 256 - 4 * hh - 59); asm volatile("" : "+v"(bp));
#pragma unroll
                    for (int r = 0; r < 16; ++r) { p0[r] += bp[59 - ((r & 3) + 8 * (r >> 2))]; p1[r] += bp[27 - ((r & 3) + 8 * (r >> 2))]; } }
            }
            {
                float mx = att_max3(p0[0], p0[1], p1[0]), mb = att_max3(p0[2], p0[3], p1[1]); mx = att_max3(mx, p1[2], p1[3]);
#pragma unroll
                for (int r = 4; r < 16; r += 4) { mx = att_max3(mx, p0[r], p0[r + 1]); mb = att_max3(mb, p0[r + 2], p0[r + 3]); mx = att_max3(mx, p1[r], p1[r + 1]); mb = att_max3(mb, p1[r + 2], p1[r + 3]); }
                mx = __builtin_fmaxf(mx, mb);
                { auto rr = __builtin_amdgcn_permlane32_swap(__builtin_bit_cast(unsigned, mx), __builtin_bit_cast(unsigned, mx), false, false); mx = __builtin_fmaxf(__builtin_bit_cast(float, rr[0]), __builtin_bit_cast(float, rr[1])); }
                if (__builtin_expect(first || __any(mx > 8.0f), 0)) {
                    const float dl = first ? mx : __builtin_fmaxf(mx, 0.f); first = false; mref += dl;
                    const float f = __builtin_amdgcn_exp2f(-dl); lrun *= f;
#pragma unroll
                    for (int r = 0; r < 16; ++r) { p0[r] -= dl; p1[r] -= dl; o0[r] *= f; o1[r] *= f; negm[r] = -mref; }
                    asm volatile("" : "+v"(negm));
                }
                float sa = 0.f, sb = 0.f, sc2 = 0.f, sd = 0.f;
#pragma unroll
                for (int r = 0; r < 16; ++r) { p0[r] = __builtin_amdgcn_exp2f(p0[r]); p1[r] = __builtin_amdgcn_exp2f(p1[r]); }
#pragma unroll
                for (int r = 0; r < 16; r += 2) { sa = att_fadd(sa, p0[r]); sb = att_fadd(sb, p0[r + 1]); sc2 = att_fadd(sc2, p1[r]); sd = att_fadd(sd, p1[r + 1]); }
                lrun += att_fadd(att_fadd(sa, sb), att_fadd(sc2, sd));
            }
            u32x4 pw[4];
            pw[0] = (u32x4){cvtpk(p0[0], p0[1]), cvtpk(p0[2], p0[3]), cvtpk(p0[4], p0[5]), cvtpk(p0[6], p0[7])};
            pw[1] = (u32x4){cvtpk(p0[8], p0[9]), cvtpk(p0[10], p0[11]), cvtpk(p0[12], p0[13]), cvtpk(p0[14], p0[15])};
            pw[2] = (u32x4){cvtpk(p1[0], p1[1]), cvtpk(p1[2], p1[3]), cvtpk(p1[4], p1[5]), cvtpk(p1[6], p1[7])};
            pw[3] = (u32x4){cvtpk(p1[8], p1[9]), cvtpk(p1[10], p1[11]), cvtpk(p1[12], p1[13]), cvtpk(p1[14], p1[15])};
#pragma unroll
            for (int s = 0; s < 4; ++s) {
                const bf16x8 pf = __builtin_bit_cast(bf16x8, pw[s]);
                if (MODE & 2) { asm volatile("" :: "v"(vfr[s][0]), "v"(vfr[s][1]), "v"(pf)); }
                else { o0 = __builtin_amdgcn_mfma_f32_32x32x16_bf16(vfr[s][0], pf, o0, 0, 0, 0); o1 = __builtin_amdgcn_mfma_f32_32x32x16_bf16(vfr[s][1], pf, o1, 0, 0, 0); }
            }
        }
        if (kt < kt_hi) { const int nout = (kt_hi - kt - 1 < 2 ? kt_hi - kt - 1 : 2); att_wait(nout * npt); }
        asm volatile("s_waitcnt lgkmcnt(0)" ::: "memory");
        __builtin_amdgcn_s_barrier(); asm volatile("" ::: "memory");
    }
#undef ATT_ISSUE
    if (wid >= 4) __builtin_amdgcn_s_setprio(0);
    const float ltot = lrun + __shfl_xor(lrun, 32); const float il = 1.0f / ltot;
    bf16_t* orow = O + (size_t)(q0 + r32) * ldo;
#pragma unroll
    for (int g = 0; g < 4; ++g) {
        u32x2 w0, w1; w0.x = cvtpk(o0[4 * g] * il, o0[4 * g + 1] * il); w0.y = cvtpk(o0[4 * g + 2] * il, o0[4 * g + 3] * il);
        w1.x = cvtpk(o1[4 * g] * il, o1[4 * g + 1] * il); w1.y = cvtpk(o1[4 * g + 2] * il, o1[4 * g + 3] * il);
        *(u32x2*)(orow + 8 * g + 4 * hh) = w0; *(u32x2*)(orow + 32 + 8 * g + 4 * hh) = w1;
    }
}
template <int MODE = 0> __device__ __forceinline__ void p4_attention(KP P, Frame& F) {
    unsigned char* ws = P->ws;
    const bf16_t* QA = (const bf16_t*)(ws + WS_QA); const bf16_t* KN = (const bf16_t*)(ws + WS_KN); const bf16_t* VA = (const bf16_t*)(ws + WS_VA); const bf16_t* KR = (const bf16_t*)(ws + WS_KR);
    const bf16_t* QB = (const bf16_t*)(ws + WS_QB); const bf16_t* KB = (const bf16_t*)(ws + WS_KB); const bf16_t* VB = (const bf16_t*)(ws + WS_VB);
    bf16_t* OA = (bf16_t*)(ws + WS_OAB); bf16_t* OB = OA + (size_t)TT * 512;
#ifndef ATT_NOMLA
    for (int p = F.vcu; p < NBF * 64; p += F.G) {
        const int bh = p >> 3, s = p & 7, b = bh >> 3, h = bh & 7; const size_t rb = (size_t)b * SEQ;
#pragma unroll 1
        for (int k = 0; k < 2; ++k) { const int qb = k ? s : 15 - s;
            attn_unit<true, MODE>(F, QA + rb * 768 + h * 64, 768, QA + rb * 768 + 512 + h * 32, 768, KN + rb * 512 + h * 64, 512, KR + rb * 32, 32, VA + rb * 512 + h * 64, 512, OA + rb * 512 + h * 64, 512, qb, nullptr); }
    }
#endif
#ifndef ATT_NOBAND
    for (int u = F.vcu; u < NBF * 128; u += F.G) {
        const int bh = u >> 4, qb = u & 15, b = bh >> 3, h = bh & 7; const size_t rb = (size_t)b * SEQ;
        attn_unit<false, MODE>(F, QB + rb * 512 + h * 64, 512, nullptr, 0, KB + rb * 512 + h * 64, 512, nullptr, 0, VB + rb * 512 + h * 64, 512, OB + rb * 512 + h * 64, 512, qb, P->rel + h * 513);
    }
#endif
}
}
namespace fx {
constexpr int P7_STRIDE = 1032;
constexpr int P7_PLANE = 36 * P7_STRIDE * 2;
static_assert(2 * P7_PLANE <= P7S_OFF, "router planes");
template <bool dry> __device__ __forceinline__ void p7_route(KP P, Frame& F) {
    const int tid = F.tid, lane = F.lane, wid = F.wave;
    LAS unsigned short* Whi = (LAS unsigned short*)(F.lds); LAS unsigned short* Wlo = (LAS unsigned short*)(F.lds + P7_PLANE);
    LAS int* lcnt = (LAS int*)(F.lds + P7S_OFF);
    LAS int* lbase = lcnt + 32;
    LAS float* cvec = (LAS float*)(lcnt + 64);
    LAS int* rec = lcnt + 128;
    LAS float* recw = (LAS float*)(F.lds + P7S_OFF + 4096);
    const int RPW = (TT + F.G - 1) / F.G;
    const float* mod = (const float*)(P->ws + CTL_MOD); const float* X1 = P->out;
    const int row_lo = F.vcu * RPW, b = row_lo / SEQ; const float* sh = mod + (size_t)b * 6144 + 3072; const float* sc = sh + 1024;
    if (tid < 32) lcnt[tid] = 0;
    float cp[36];
#pragma unroll
    for (int r = 0; r < 36; ++r) cp[r] = 0.f;
    f32x4 wv[2][9]; float gmk[2], shk[2];
#pragma unroll
    for (int kk = 0; kk < 2; ++kk) { const int k = tid + 512 * kk; gmk[kk] = P->g_ffn[k] * (1.f + sc[k]); shk[kk] = sh[k];
        const f32x4* wr = (const f32x4*)(P->w_re + (size_t)k * 32);
#pragma unroll
        for (int c4 = 0; c4 < 8; ++c4) wv[kk][c4] = wr[c4];
        wv[kk][8] = *(const f32x4*)(P->w_rg + (size_t)k * 4); }
#pragma unroll
    for (int kk = 0; kk < 2; ++kk) { const int k = tid + 512 * kk;
#pragma unroll
        for (int c4 = 0; c4 < 9; ++c4)
#pragma unroll
            for (int e4 = 0; e4 < 4; ++e4) {
                const int e = c4 * 4 + e4, g = e >> 3, i8 = e & 7, rho = (c4 < 8) ? (16 * (i8 >> 2) + 4 * g + (i8 & 3)) : (32 + e4);
                const float w = wv[kk][c4][e4]; cp[rho] += shk[kk] * w;
                const float v = w * gmk[kk]; const unsigned hi = cvtpk(v, 0.f) & 0xffffu; const unsigned lo = cvtpk(v - bf_lo(hi), 0.f) & 0xffffu;
                Whi[rho * P7_STRIDE + k] = (unsigned short)hi; Wlo[rho * P7_STRIDE + k] = (unsigned short)lo; }
    }
    {
        LAS float* cw = (LAS float*)(F.lds + P7S_OFF + 6144);
#pragma unroll
        for (int r = 0; r < 36; ++r) { const float sred = wave_sum(cp[r]); if (lane == 0) cw[wid * 36 + r] = sred; }
        __syncthreads();
        if (tid < 36) { float a = 0.f;
#pragma unroll
            for (int w = 0; w < 8; ++w) a += cw[w * 36 + tid];
            float bias; if (tid < 32) { const int jt = tid >> 4, g = (tid & 15) >> 2, i = tid & 3; bias = P->b_re[8 * g + 4 * jt + i]; } else bias = P->b_rg[tid - 32];
            cvec[tid] = a + bias; }
    }
    __syncthreads();
    const int row = lane & 15, q = lane >> 4;
    const float cg = cvec[32 + q]; float cv[2][4];
#pragma unroll
    for (int jt = 0; jt < 2; ++jt)
#pragma unroll
        for (int i = 0; i < 4; ++i) cv[jt][i] = cvec[16 * jt + 4 * q + i];
    float* rinv = (float*)(P->ws + WS_RT_RINV);
    const int arow2 = 32 + (row >> 2);
    const bool has = wid * 16 < RPW;
    const int m = row_lo + wid * 16 + row;
    const f32x4* xr = (const f32x4*)(X1 + (size_t)(has ? m : row_lo) * 1024 + 8 * q);
    if (has) {
        float inv;
        { const f32x4* sq = (const f32x4*)((const float*)(P->ws + WS_SSQ_X) + (size_t)m * 16); const f32x4 s0 = sq[0], s1 = sq[1], s2 = sq[2], s3 = sq[3];
          const float ssq = (((s0[0] + s0[1]) + (s0[2] + s0[3])) + ((s1[0] + s1[1]) + (s1[2] + s1[3]))) + (((s2[0] + s2[1]) + (s2[2] + s2[3])) + ((s3[0] + s3[1]) + (s3[2] + s3[3])));
          inv = 1.0f / sqrtf(ssq * (1.f / 1024.f) + EPS); }
        if (q == 0) rinv[m] = inv;
        f32x4 acc0 = {0.f, 0.f, 0.f, 0.f}, acc1 = acc0, acc2 = acc0;
        bf16_t* h2r = (bf16_t*)(P->ws + WS_H) + (size_t)m * 1024 + 8 * q; const float* gf = P->g_ffn + 8 * q; const float* scq = sc + 8 * q; const float* shq = sh + 8 * q;
        f32x4 xq[16];
#pragma unroll
        for (int j = 0; j < 16; ++j) xq[j] = xr[(j >> 1) * 8 + (j & 1)];
#pragma unroll 1
        for (int g = 0; g < 4; ++g) {
            f32x4 xn[16];
            if (g < 3) {
#pragma unroll
                for (int j = 0; j < 16; ++j) xn[j] = xr[(8 * (g + 1) + (j >> 1)) * 8 + (j & 1)]; }
            __builtin_amdgcn_sched_barrier(0);
#pragma unroll
            for (int kk = 0; kk < 8; ++kk) {
                const int ks = 8 * g + kk; const f32x4 xa = xq[2 * kk], xb = xq[2 * kk + 1];
                u32x4 xh, xl;
                xh.x = cvtpk(xa[0], xa[1]); xh.y = cvtpk(xa[2], xa[3]); xh.z = cvtpk(xb[0], xb[1]); xh.w = cvtpk(xb[2], xb[3]);
                xl.x = cvtpk(xa[0] - bf_lo(xh.x), xa[1] - bf_hi(xh.x)); xl.y = cvtpk(xa[2] - bf_lo(xh.y), xa[3] - bf_hi(xh.y));
                xl.z = cvtpk(xb[0] - bf_lo(xh.z), xb[1] - bf_hi(xh.z)); xl.w = cvtpk(xb[2] - bf_lo(xh.w), xb[3] - bf_hi(xh.w));
                const bf16x8 bh = __builtin_bit_cast(bf16x8, xh), bl = __builtin_bit_cast(bf16x8, xl);
                const int ko = ks * 32 + 8 * q;
                const bf16x8 a0h = *(const LAS bf16x8*)(Whi + row * P7_STRIDE + ko), a0l = *(const LAS bf16x8*)(Wlo + row * P7_STRIDE + ko);
                const bf16x8 a1h = *(const LAS bf16x8*)(Whi + (16 + row) * P7_STRIDE + ko), a1l = *(const LAS bf16x8*)(Wlo + (16 + row) * P7_STRIDE + ko);
                const bf16x8 a2h = *(const LAS bf16x8*)(Whi + arow2 * P7_STRIDE + ko), a2l = *(const LAS bf16x8*)(Wlo + arow2 * P7_STRIDE + ko);
                acc0 = __builtin_amdgcn_mfma_f32_16x16x32_bf16(a0h, bh, acc0, 0, 0, 0); acc0 = __builtin_amdgcn_mfma_f32_16x16x32_bf16(a0l, bh, acc0, 0, 0, 0); acc0 = __builtin_amdgcn_mfma_f32_16x16x32_bf16(a0h, bl, acc0, 0, 0, 0);
                acc1 = __builtin_amdgcn_mfma_f32_16x16x32_bf16(a1h, bh, acc1, 0, 0, 0); acc1 = __builtin_amdgcn_mfma_f32_16x16x32_bf16(a1l, bh, acc1, 0, 0, 0); acc1 = __builtin_amdgcn_mfma_f32_16x16x32_bf16(a1h, bl, acc1, 0, 0, 0);
                acc2 = __builtin_amdgcn_mfma_f32_16x16x32_bf16(a2h, bh, acc2, 0, 0, 0); acc2 = __builtin_amdgcn_mfma_f32_16x16x32_bf16(a2l, bh, acc2, 0, 0, 0); acc2 = __builtin_amdgcn_mfma_f32_16x16x32_bf16(a2h, bl, acc2, 0, 0, 0);
                const f32x4 ga = *(const f32x4*)(gf + ks * 32), gb = *(const f32x4*)(gf + ks * 32 + 4), sa = *(const f32x4*)(scq + ks * 32), sb = *(const f32x4*)(scq + ks * 32 + 4);
                const f32x4 ha = *(const f32x4*)(shq + ks * 32), hb = *(const f32x4*)(shq + ks * 32 + 4);
                f32x4 ya, yb;
#pragma unroll
                for (int e = 0; e < 4; ++e) { ya[e] = xa[e] * inv * (ga[e] * (1.f + sa[e])) + ha[e]; yb[e] = xb[e] * inv * (gb[e] * (1.f + sb[e])) + hb[e]; }
                *(u32x4*)(h2r + ks * 32) = pack8(ya, yb);
            }
            if (g < 3) {
#pragma unroll
                for (int j = 0; j < 16; ++j) xq[j] = xn[j]; }
        }
        const float lgq = inv * acc2[0] + cg;
        float gm1 = fmaxf(lgq, __shfl_xor(lgq, 16)); gm1 = fmaxf(gm1, __shfl_xor(gm1, 32));
        float es = __expf(lgq - gm1); es += __shfl_xor(es, 16); es += __shfl_xor(es, 32);
        int cand = (lgq == gm1) ? q : 4; { const int o1 = __shfl_xor(cand, 16); cand = cand < o1 ? cand : o1; const int o2 = __shfl_xor(cand, 32); cand = cand < o2 ? cand : o2; }
        const float gw = 1.f / es;
        float ev[8];
#pragma unroll
        for (int i = 0; i < 4; ++i) { ev[i] = inv * acc0[i] + cv[0][i]; ev[4 + i] = inv * acc1[i] + cv[1][i]; }
        float m1 = -1e30f; int i1 = 0;
#pragma unroll
        for (int j = 0; j < 8; ++j) if (ev[j] > m1) { m1 = ev[j]; i1 = j; }
        float m2 = -1e30f; int i2 = 0;
#pragma unroll
        for (int j = 0; j < 8; ++j) if (j != i1 && ev[j] > m2) { m2 = ev[j]; i2 = j; }
        const float p2 = __expf(m2 - m1), w1 = gw / (1.f + p2), w2 = gw * p2 / (1.f + p2);
        if (q == cand) {
            const int rl = wid * 16 + row, e1 = q * 8 + i1, e2 = q * 8 + i2;
            const int r1 = __hip_atomic_fetch_add(lcnt + e1, 1, __ATOMIC_RELAXED, __HIP_MEMORY_SCOPE_WORKGROUP), r2 = __hip_atomic_fetch_add(lcnt + e2, 1, __ATOMIC_RELAXED, __HIP_MEMORY_SCOPE_WORKGROUP);
            rec[rl * 4 + 0] = e1; rec[rl * 4 + 1] = e2; rec[rl * 4 + 2] = r1; rec[rl * 4 + 3] = r2; recw[rl * 2] = w1; recw[rl * 2 + 1] = w2;
        }
    }
    __syncthreads();
    unsigned* gcnt = (unsigned*)(P->ws + CTL_CNT);
    if (tid < 32) lbase[tid] = dry ? 0 : (int)__hip_atomic_fetch_add(gcnt + 64 * tid, (unsigned)lcnt[tid], __ATOMIC_RELAXED, __HIP_MEMORY_SCOPE_AGENT);
    __syncthreads();
    int* rt_e = (int*)(P->ws + WS_RT_E); int* rt_rank = (int*)(P->ws + WS_RT_RANK); float* rt_w = (float*)(P->ws + WS_RT_W);
    if (!dry && tid < RPW && row_lo + tid < TT) { const int mm = row_lo + tid; const int e1 = rec[tid * 4], e2 = rec[tid * 4 + 1];
        rt_e[mm * 2] = e1; rt_e[mm * 2 + 1] = e2; rt_rank[mm * 2] = lbase[e1] + rec[tid * 4 + 2]; rt_rank[mm * 2 + 1] = lbase[e2] + rec[tid * 4 + 3];
        rt_w[mm * 2] = recw[tid * 2]; rt_w[mm * 2 + 1] = recw[tid * 2 + 1];
        int* elist = (int*)(P->ws + WS_ELIST); float* ewt = (float*)(P->ws + WS_EWT);
        const int x1i = lbase[e1] + rec[tid * 4 + 2], x2i = lbase[e2] + rec[tid * 4 + 3];
        elist[(size_t)e1 * TT + x1i] = mm; ewt[(size_t)e1 * TT + x1i] = recw[tid * 2]; elist[(size_t)e2 * TT + x2i] = mm; ewt[(size_t)e2 * TT + x2i] = recw[tid * 2 + 1]; }
    __syncthreads();
}
__device__ __forceinline__ void moe_tables(KP P, Frame& F, LAS int* tab, LAS int* toff) {
    const unsigned* gcnt = (const unsigned*)(P->ws + CTL_CNT);
    LAS int* cnt_s = toff + 40;
    if (F.tid < 32) cnt_s[F.tid] = (int)__hip_atomic_load(gcnt + 64 * F.tid, __ATOMIC_RELAXED, __HIP_MEMORY_SCOPE_AGENT);
    __syncthreads();
    if (F.tid == 0) {
        int acc = 0;
        for (int e = 0; e < 32; ++e) { const int c = cnt_s[e]; const int nt = (c + 255) >> 8; toff[e] = acc;
            for (int j = 0; j < nt; ++j) tab[1 + acc + j] = e; acc += nt; }
        toff[32] = acc; tab[0] = acc;
    }
    __syncthreads();
}
__device__ __forceinline__ void p11_final(KP P, Frame& F, const LAS int* toff, const bool dry = false) {
    const int gw = F.vcu * NWAVES + F.wave, NGW = F.G * NWAVES, lane = F.lane;
    const float* mod = (const float*)(P->ws + CTL_MOD); const int* rt_e = (const int*)(P->ws + WS_RT_E); const int* rt_rank = (const int*)(P->ws + WS_RT_RANK); const bf16_t* YB = (const bf16_t*)(P->ws + WS_YB);
    for (int m0 = gw * 2; m0 < TT; m0 += NGW * 2) {
        f32x4 xv[2][4]; u32x2 ya[2][4], yc[2][4]; f32x4 gq[2][4];
#pragma unroll
        for (int rr = 0; rr < 2; ++rr) { const int m = m0 + rr; const float* gt = mod + (size_t)(m / SEQ) * 6144 + 5120;
            const int p1 = toff[rt_e[m * 2]] * 256 + rt_rank[m * 2], p2 = toff[rt_e[m * 2 + 1]] * 256 + rt_rank[m * 2 + 1];
            const u32x2* y1 = (const u32x2*)(YB + (size_t)p1 * 1024) + lane; const u32x2* y2 = (const u32x2*)(YB + (size_t)p2 * 1024) + lane;
            const f32x4* xr = (const f32x4*)(P->out + (size_t)m * 1024) + lane;
#pragma unroll
            for (int j = 0; j < 4; ++j) { xv[rr][j] = xr[64 * j]; ya[rr][j] = y1[64 * j]; yc[rr][j] = y2[64 * j]; gq[rr][j] = *(const f32x4*)(gt + 4 * lane + 256 * j); } }
#pragma unroll
        for (int rr = 0; rr < 2; ++rr) { const int m = m0 + rr;
            f32x4 v[4]; float s = 0.f;
#pragma unroll
            for (int j = 0; j < 4; ++j) { const f32x4 x4 = xv[rr][j]; const u32x2 a = ya[rr][j], c = yc[rr][j]; const f32x4 g = gq[rr][j];
                v[j][0] = x4[0] + g[0] * (bf_lo(a.x) + bf_lo(c.x)); v[j][1] = x4[1] + g[1] * (bf_hi(a.x) + bf_hi(c.x));
                v[j][2] = x4[2] + g[2] * (bf_lo(a.y) + bf_lo(c.y)); v[j][3] = x4[3] + g[3] * (bf_hi(a.y) + bf_hi(c.y));
                s += (v[j][0] * v[j][0] + v[j][1] * v[j][1]) + (v[j][2] * v[j][2] + v[j][3] * v[j][3]); }
            const float inv = 1.0f / sqrtf(wave_sum(s) * (1.f / 1024.f) + EPS);
            f32x4* xw = (f32x4*)(P->out + (size_t)m * 1024) + lane;
#pragma unroll
            for (int j = 0; j < 4; ++j) { const f32x4 g = *(const f32x4*)(P->g_final + 4 * lane + 256 * j); f32x4 o;
#pragma unroll
                for (int e = 0; e < 4; ++e) o[e] = v[j][e] * inv * g[e];
                if (dry) ((f32x4*)(P->ws + WS_H) + (size_t)m * 256 + lane)[64 * j] = o; else xw[64 * j] = o; }
        }
    }
}

constexpr int N_PHASES = 12;
#ifndef ALIGN56
#define ALIGN56 true
#endif
__global__ void __launch_bounds__(NTHR, 2) mega_fwd(Params P_by_value) {
    KP P = (KP)__builtin_amdgcn_kernarg_segment_ptr();
    extern __shared__ __attribute__((aligned(16))) unsigned char lds_raw[];
    Frame F;
    F.lds = (LAS unsigned char*)lds_raw;
    F.tid = threadIdx.x; F.lane = F.tid & 63; F.wave = __builtin_amdgcn_readfirstlane(F.tid >> 6);
    F.G = gridDim.x; { const int bx = blockIdx.x; F.vcu = (F.G % 8 == 0) ? (bx % 8) * (F.G / 8) + bx / 8 : bx; }
    unsigned char* ws = P->ws;
    F.ctl = (gu32*)(ws + WS_CTL);
    volatile LAS unsigned* MISC = (volatile LAS unsigned*)(F.lds + LCTL_OFF);
    LAS int* tab = (LAS int*)(F.lds + LCTL_OFF + 256);
    LAS int* toff = (LAS int*)(F.lds + LCTL_OFF + 256 + 2048);
    for (int u = F.tid; u < (LDS_BYTES - LCTL_OFF) / 4; u += NTHR) ((LAS unsigned*)(F.lds + LCTL_OFF))[u] = 0u;
    __syncthreads();
    XcdBarrier bar = xcd_barrier_post((unsigned*)(F.ctl + CW_BAR) + P->li * XCD_BAR_WORDS, MISC + 8);
    const int lo = P->ph_lo, hi = P->ph_hi;
#ifndef PH_MASK
#define PH_MASK 0xFFF
#endif
#define IN(k) ((((PH_MASK) >> (k)) & 1) && lo <= (k) && (k) < hi)
#define SEAM(k) do { if ((k) != 8 && IN(k) && IN((k) + 1)) xcd_barrier(bar); } while (0)
#define REFRESH() do { int t_ = threadIdx.x; asm volatile("" : "+v"(t_)); F.tid = t_; F.lane = t_ & 63; } while (0)
    LAS unsigned char* ring = F.lds + RING_OFF;
    bf16_t* H = (bf16_t*)(ws + WS_H);
    float* ssq_q = (float*)(ws + WS_SSQ_Q); float* ssq_kv = (float*)(ws + WS_SSQ_KV);
    bf16_t* GA = (bf16_t*)P->out; bf16_t* GB = GA + (size_t)TT * 1024;

#ifndef PH_REPEAT
#define PH_REPEAT 0
#endif
#define PHASE(k, ...) do { if (IN(k)) { REFRESH(); { __VA_ARGS__ } if (((PH_REPEAT) >> (k)) & 1) { xcd_barrier(bar); REFRESH(); { __VA_ARGS__ } } } SEAM(k); } while (0)
    PHASE(0, p0_prologue(P, F););
    PHASE(1, p1_norm(P, F););
    PHASE(2, {
        pg8::Gemm g{H, (const bf16_t*)(ws + WS_WIN), TT, NPROJ, 1024}; pg8::StaticOrder S; S.init(TT, NPROJ, F.G, (int)blockIdx.x);
        EpiProj E{(bf16_t*)(ws + WS_QLAT), (bf16_t*)(ws + WS_KVL), (bf16_t*)(ws + WS_QB), (bf16_t*)(ws + WS_KB), (bf16_t*)(ws + WS_VB), GA, GB, ssq_q, ssq_kv};
        pg8::gemm_phase<EpiProj, pg8::StaticOrder, true, true>(ring, g, S, E); });
    PHASE(3, {
        { pg8::Gemm g{(const bf16_t*)(ws + WS_QLAT), (const bf16_t*)(ws + WS_WUQ), TT, 768, 256}; pg8::StaticOrder S; S.init(TT, 768, F.G, (int)blockIdx.x);
          EpiQA E{(bf16_t*)(ws + WS_QA), ssq_q, (const float*)(ws + WS_CS)};
          pg8::gemm_phase<EpiQA, pg8::StaticOrder, true, true>(ring, g, S, E); }
        { pg8::Gemm g{(const bf16_t*)(ws + WS_KVL), (const bf16_t*)(ws + WS_WKV), TT, 1024, 256}; pg8::StaticOrder S; S.init(TT, 1024, F.G, (int)blockIdx.x);
          EpiKV E{(bf16_t*)(ws + WS_KN), (bf16_t*)(ws + WS_VA), ssq_kv};
          pg8::gemm_phase<EpiKV, pg8::StaticOrder, true, true>(ring, g, S, E); }
        REFRESH();
        p3_krope(P, F); });
#ifdef ATT_PROBE
    if (IN(4)) { REFRESH(); p4_attention<ATT_PROBE>(P, F); xcd_barrier(bar); }
#endif
    PHASE(4, p4_attention<0>(P, F););
    PHASE(5, {
        pg8::Gemm g{(const bf16_t*)(ws + WS_OAB), (const bf16_t*)(ws + WS_WOAB), 2 * TT, 2048, 512}; PairOrder S; S.init(F.G, (int)blockIdx.x);
        EpiMerge E{(bf16_t*)(ws + WS_MERGED), GA, GB};
        pg8::gemm_phase<EpiMerge, PairOrder, ALIGN56, true>(ring, g, S, E); });
    PHASE(6, {
        pg8::Gemm g{(const bf16_t*)(ws + WS_MERGED), (const bf16_t*)(ws + WS_WOUT), TT, 1024, 1024}; pg8::StaticOrder S; S.init(TT, 1024, F.G, (int)blockIdx.x);
        EpiResid E{P->x, P->out, (const float*)(ws + CTL_MOD), (float*)(ws + WS_SSQ_X)};
        pg8::gemm_phase<EpiResid, pg8::StaticOrder, ALIGN56, true>(ring, g, S, E); });
    if (IN(7) && ((PH_REPEAT >> 7) & 1)) { REFRESH(); p7_route<true>(P, F); xcd_barrier(bar); }
    if (IN(7)) { REFRESH(); p7_route<false>(P, F); } SEAM(7);
    PHASE(9, {
        moe_tables(P, F, tab, toff);
        pg8::Gemm g{(const bf16_t*)(ws + WS_H), (const bf16_t*)(ws + WS_WGU), MOE_ROWS, 32 * 512, 1024}; MoeOrderT<true> S{(const int*)(ws + WS_ELIST), toff, tab, 2, F.G, F.vcu};
        EpiGU E{(bf16_t*)(ws + WS_HID), (const float*)(ws + WS_EWT), tab, toff};
        pg8::gemm_phase<EpiGU, MoeOrderT<true>, true, true>(ring, g, S, E); });
    PHASE(10, {
        if (!IN(9)) moe_tables(P, F, tab, toff);
        pg8::Gemm g{(const bf16_t*)(ws + WS_HID), (const bf16_t*)(ws + WS_WD), MOE_ROWS, 32 * 1024, 256}; MoeOrder S{nullptr, toff, tab, 4, F.G, F.vcu};
        EpiDown E{(bf16_t*)(ws + WS_YB)};
        pg8::gemm_phase<EpiDown, MoeOrder, true, true>(ring, g, S, E); });
    if (IN(11) && ((PH_REPEAT >> 11) & 1)) { REFRESH(); p11_final(P, F, toff, true); xcd_barrier(bar); }
    if (IN(11)) { REFRESH(); if (!IN(10)) moe_tables(P, F, tab, toff); p11_final(P, F, toff); }
#undef IN
#undef SEAM
}

static void fill_params(Params& p, void* const* d_in, float* out, void* ws) {
    p.x = (const float*)d_in[0]; p.c = (const float*)d_in[1]; p.pos = (const int*)d_in[2]; p.w_ada = (const float*)d_in[3]; p.b_ada = (const float*)d_in[4];
    p.g_mix = (const float*)d_in[5]; p.w_in = (const float*)d_in[6]; p.g_q = (const float*)d_in[7]; p.w_uq = (const float*)d_in[8]; p.g_kv = (const float*)d_in[9];
    p.w_uk = (const float*)d_in[10]; p.w_uv = (const float*)d_in[11]; p.rel = (const float*)d_in[12]; p.w_oa = (const float*)d_in[13]; p.w_ob = (const float*)d_in[14];
    p.w_out = (const float*)d_in[15]; p.g_ffn = (const float*)d_in[16]; p.w_rg = (const float*)d_in[17]; p.b_rg = (const float*)d_in[18]; p.w_re = (const float*)d_in[19];
    p.b_re = (const float*)d_in[20]; p.w_gate = (const float*)d_in[21]; p.w_up = (const float*)d_in[22]; p.w_down = (const float*)d_in[23]; p.g_final = (const float*)d_in[24];
    p.out = out; p.ws = (unsigned char*)ws;
}
static bool launch(void* const* d_in, float* out, void* ws, hipStream_t stream, int mode, int ph_lo = 0, int ph_hi = N_PHASES, int li = 0, bool do_memset = true) {
    static int grid = 0;
    if (grid == 0) {
        int dev = 0, cus = 0;
        if (hipGetDevice(&dev) != hipSuccess || hipDeviceGetAttribute(&cus, hipDeviceAttributeMultiprocessorCount, dev) != hipSuccess) { fprintf(stderr, "kernel_launch: device query failed\n"); grid = -1; return false; }
        if (hipFuncSetAttribute((const void*)mega_fwd, hipFuncAttributeMaxDynamicSharedMemorySize, LDS_BYTES) != hipSuccess) { fprintf(stderr, "kernel_launch: hipFuncSetAttribute failed\n"); grid = -1; return false; }
        int per_cu = 0;
        if (hipOccupancyMaxActiveBlocksPerMultiprocessor(&per_cu, (const void*)mega_fwd, NTHR, LDS_BYTES) != hipSuccess || per_cu < 1) fprintf(stderr, "kernel_launch: note: occupancy query says %d workgroups per CU\n", per_cu);
        (void)hipGetLastError();
        grid = cus;
        if (grid != 256) fprintf(stderr, "kernel_launch: note: %d CUs (built for 256)\n", grid);
    }
    if (grid < 0) return false;
    if (do_memset) (void)hipMemsetAsync((char*)ws + WS_CTL, 0, CTL_ZERO_BYTES, stream);
    Params p{}; fill_params(p, d_in, out, ws); p.li = li;
    if (mode == 0) { p.ph_lo = ph_lo; p.ph_hi = ph_hi; hipLaunchKernelGGL(mega_fwd, dim3(grid), dim3(NTHR), LDS_BYTES, stream, p); }
    else for (int k = ph_lo; k < ph_hi; ++k) { p.ph_lo = k; p.ph_hi = k + 1; hipLaunchKernelGGL(mega_fwd, dim3(grid), dim3(NTHR), LDS_BYTES, stream, p); }
    return true;
}
}
#ifndef DBG
#define DBG 0
#endif
#ifndef LAUNCH_MODE
#define LAUNCH_MODE 0
#endif
extern "C" void kernel_launch(void* const* d_in, const int* in_sizes, int n_in, void* d_out, int out_size, void* d_ws, size_t ws_size, hipStream_t stream) {
#if !DBG
    fx::launch(d_in, (float*)d_out, d_ws, stream, LAUNCH_MODE);
#else
    using namespace fx;
    constexpr size_t WS_OUTF = 152 * MiB, WS_ACC = 168 * MiB, WS_NAIVE = 176 * MiB;
    static_assert(WS_FAST_END <= WS_OUTF, "debug map");
    unsigned char* ws = (unsigned char*)d_ws; float* outf = (float*)(ws + WS_OUTF); float* acc = (float*)(ws + WS_ACC);
    nv::In in; nv::fill_in(in, d_in);
    nv::Scratch sc; sc.carve((float*)(ws + WS_NAIVE));
    (void)hipMemsetAsync(acc, 0, 4096, stream);
    hipLaunchKernelGGL(nv::k_mod, dim3(6144 / 256, 8), dim3(256), 0, stream, in.c, in.w_ada, in.b_ada, sc.mod);
    for (int b = nv::NB - 1; b >= 0; --b) nv::forward_batch(in, sc, b, (float*)d_out, stream);
    const int R = TT;
#define CMPB(s, F, ldf, fs, Rp, ldr, rows, cols, rsig) hipLaunchKernelGGL(dbg::k_cmp<true>, dim3(256), dim3(256), 0, stream, (const void*)(F), ldf, fs, Rp, ldr, rows, cols, rsig, acc, s)
#define CMPF(s, F, ldf, fs, Rp, ldr, rows, cols, rsig) hipLaunchKernelGGL(dbg::k_cmp<false>, dim3(256), dim3(256), 0, stream, (const void*)(F), ldf, fs, Rp, ldr, rows, cols, rsig, acc, s)
    launch(d_in, outf, d_ws, stream, LAUNCH_MODE, 0, 6, 0, true);
    CMPF(1, ws + CTL_MOD, 6144, 1.f, sc.mod, 6144, NBF, 6144, 0);
    CMPB(2, ws + WS_H, 1024, 1.f, sc.h, 1024, R, 1024, 0);
    CMPB(3, ws + WS_QLAT, 256, 1.f, sc.proj + nv::C_QLAT, nv::INW, R, 256, 0);
    CMPB(4, ws + WS_KVL, 256, 1.f, sc.proj + nv::C_KVLAT, nv::INW, R, 160, 0);
    CMPB(5, ws + WS_QB, 512, 1.f / C2B, sc.proj + nv::C_QB, nv::INW, R, 512, 0);
    CMPB(6, ws + WS_KB, 512, 1.f, sc.proj + nv::C_KB, nv::INW, R, 512, 0);
    CMPB(7, ws + WS_VB, 512, 1.f, sc.proj + nv::C_VB, nv::INW, R, 512, 0);
    CMPB(8, (unsigned short*)outf, 1024, 1.f, sc.proj + nv::C_GA, nv::INW, R, 1024, 1);
    CMPB(9, (unsigned short*)outf + (size_t)TT * 1024, 1024, 1.f, sc.proj + nv::C_GB, nv::INW, R, 1024, 1);
    for (int h = 0; h < 8; ++h) { CMPB(10, (unsigned short*)(ws + WS_QA) + h * 64, 768, 1.f / C2A, sc.qa + h * 96, 768, R, 64, 0); CMPB(11, (unsigned short*)(ws + WS_QA) + 512 + h * 32, 768, 1.f / C2A, sc.qa + h * 96 + 64, 768, R, 32, 0); }
    CMPB(12, ws + WS_KN, 512, 1.f, sc.kn, 512, R, 512, 0);
    CMPB(13, ws + WS_VA, 512, 1.f, sc.va, 512, R, 512, 0);
    CMPB(14, ws + WS_KR, 32, 1.f, sc.kr, 32, R, 32, 0);
    CMPB(15, ws + WS_OAB, 512, 1.f, sc.oa, 512, R, 512, 0);
    CMPB(16, (unsigned short*)(ws + WS_OAB) + (size_t)TT * 512, 512, 1.f, sc.ob, 512, R, 512, 0);
    CMPB(17, ws + WS_MERGED, 1024, 1.f, sc.A, 1024, R, 1024, 0);
    launch(d_in, outf, d_ws, stream, LAUNCH_MODE, 6, 7, 1, false);
    CMPF(18, outf, 1024, 1.f, sc.x1, 1024, R, 1024, 0);
    launch(d_in, outf, d_ws, stream, LAUNCH_MODE, 7, N_PHASES, 2, false);
    hipLaunchKernelGGL(dbg::k_cmp_route, dim3((R + 255) / 256), dim3(256), 0, stream, (const int*)(ws + WS_RT_E), (const float*)(ws + WS_RT_W), sc.rt_e, sc.rt_w, R, acc, 20);
    CMPF(21, outf, 1024, 1.f, (const float*)d_out, 1024, R, 1024, 0);
    hipLaunchKernelGGL(dbg::k_scale, dim3(1024), dim3(256), 0, stream, (float*)d_out, (size_t)nv::NB * nv::S * 1024, acc, 22, 0.03f, DBG_FIRST);
#endif
}
```

```cpp
#include <hip/hip_runtime.h>
#include <hip/hip_bf16.h>
#include <cstdio>
#include <cstdint>
#include <cmath>
namespace pg8 {
#define PG8_LAS __attribute__((address_space(3)))
typedef unsigned short bf16_t;
typedef short bf16x8 __attribute__((ext_vector_type(8)));
typedef float f32x4 __attribute__((ext_vector_type(4)));
typedef unsigned u32x4 __attribute__((ext_vector_type(4)));
constexpr int BM = 256, BK = 64, HALF = 128, HTB = HALF * BK * 2  , STAGE_BYTES = 8 * HTB, NXCD = 8, WGM = 8;

__host__ __device__ __forceinline__ int lds_byte(int r, int c) { const int st = (r >> 4) * 2 + (c >> 5), rr = r & 15, cc = c & 31, ob = rr * 64 + cc * 2; return st * 1024 + (ob ^ (((ob >> 9) & 1) << 5)); }
__host__ __device__ __forceinline__ void stage_rc(int b, int& R, int& C) { const int st = b / 1024, sb = b % 1024, swz = sb ^ (((sb >> 9) & 1) << 5); R = (st >> 1) * 16 + swz / 64; C = (st & 1) * 32 + (swz % 64) / 2; }
__host__ __device__ __forceinline__ int perm32(int rho) { const int n = rho >> 4, i = rho & 15; return 8 * (i >> 2) + 4 * n + (i & 3); }

struct Unit { int pm, pn; };
struct Gemm { const bf16_t* A; const bf16_t* Bt; int M, N, K; };

struct StaticOrder {
    static constexpr bool GATHER = false; __device__ __forceinline__ unsigned a_row_off(int) const { return 0u; }
    int nM, nN, nwg, G, c;
    __host__ __device__ void init(int M, int N, int G_, int c_) { nM = M / BM; nN = N / BM; nwg = nM * nN; G = G_; c = c_; }
    __host__ __device__ bool next(int i, Unit& u) const {
        const long L = (long)i * G + c; if (L >= nwg) return false;
        int wgid = (int)L; { const int q = nwg / NXCD, r = nwg % NXCD, xcd = wgid % NXCD, off = wgid / NXCD; wgid = (xcd < r ? xcd * (q + 1) : r * (q + 1) + (xcd - r) * q) + off; }
        const int nig = WGM * nN, gid = wgid / nig, fm = gid * WGM, gsz = (nM - fm) < WGM ? (nM - fm) : WGM;
        u.pm = fm + ((wgid % nig) % gsz); u.pn = (wgid % nig) / gsz; return true;
    }
    __device__ __forceinline__ void a_ready(const Unit&) const {}
    __device__ __forceinline__ void done(const Unit&) const {}
};
__device__ __forceinline__ unsigned cvt_pk_bf16(float lo, float hi) { unsigned r; asm volatile("v_cvt_pk_bf16_f32 %0, %1, %2" : "=v"(r) : "v"(lo), "v"(hi)); return r; }
typedef float f32x2 __attribute__((ext_vector_type(2)));
template <class Epi, class Sched, bool ALIGN_EPI = false, bool SP2 = false>
__device__ __forceinline__ void gemm_phase(PG8_LAS unsigned char* lds, const Gemm g, const Sched& S, const Epi& E) {
    const int tid = threadIdx.x, wid = __builtin_amdgcn_readfirstlane(tid >> 6), lane = tid & 63, wr = wid >> 2, wc = wid & 3, fr = lane & 15, fq = lane >> 4;
    const int K = g.K, nt = K / BK;
    unsigned voffA[2], voffB[2];
    constexpr bool GA = Sched::GATHER;
    unsigned gC[2][2] = {{0u, 0u}, {0u, 0u}}, gN[2][2] = {{0u, 0u}, {0u, 0u}}; int gR[2] = {0, 0}; unsigned gCc[2] = {0u, 0u};
#pragma unroll
    for (int i = 0; i < 2; ++i) { int R, C; stage_rc(tid * 16 + i * 8192, R, C); const int Rb = Epi::PERM ? ((R & ~31) + perm32(R & 31)) : R;
        voffA[i] = (unsigned)(R * K + C) * 2u; voffB[i] = (unsigned)(Rb * K + C) * 2u; gR[i] = R; gCc[i] = (unsigned)C * 2u; }
#define PG8_GOFF(dst, u) do { _Pragma("unroll") for (int h_ = 0; h_ < 2; ++h_) _Pragma("unroll") for (int i_ = 0; i_ < 2; ++i_) dst[h_][i_] = S.a_row_off((u).pm * BM + h_ * HALF + gR[i_]) + gCc[i_]; } while (0)
#define PG8_STAGE_A(bufoff, h, base, nx) do { if constexpr (GA) { unsigned vv_[2] = {(nx) ? gN[h][0] : gC[h][0], (nx) ? gN[h][1] : gC[h][1]}; PG8_STAGE(bufoff, base, vv_); } else { PG8_STAGE(bufoff, (base) + (h) * hstep, voffA); } } while (0)
    const size_t kstep = (size_t)(BK * 2);
    const size_t hstep = (size_t)HALF * K * 2;
    const size_t tstep = 2 * hstep;
    const unsigned ldsw = (unsigned)wid * 1024u;
    const int aoff = lds_byte(wr * 64 + fr, fq * 8), boff = lds_byte(wc * 32 + fr, fq * 8);
#define PG8_SA(b, h) (((b) * 2 + (h)) * HTB)
#define PG8_SB(b, h) ((4 + (b) * 2 + (h)) * HTB)
#define PG8_STAGE(bufoff, gbase, voff) do { _Pragma("unroll") for (int _i = 0; _i < 2; ++_i) \
        __builtin_amdgcn_global_load_lds((const unsigned*)((const char*)(gbase) + (voff)[_i]), (PG8_LAS unsigned*)(lds + (bufoff) + ldsw + _i * 8192), 16, 0, 0); } while (0)
#define PG8_LDA(dst, b, h) do { _Pragma("unroll") for (int m = 0; m < 4; ++m) _Pragma("unroll") for (int k = 0; k < 2; ++k) dst[m][k] = *(const PG8_LAS bf16x8*)(lds + PG8_SA(b, h) + aoff + m * 2048 + k * 1024); } while (0)
#define PG8_LDB(dst, b, h) do { _Pragma("unroll") for (int n = 0; n < 2; ++n) _Pragma("unroll") for (int k = 0; k < 2; ++k) dst[n][k] = *(const PG8_LAS bf16x8*)(lds + PG8_SB(b, h) + boff + n * 2048 + k * 1024); } while (0)
#define PG8_MMA(ai, bj, At, Bt) do { __builtin_amdgcn_s_setprio(1); _Pragma("unroll") for (int m = 0; m < 4; ++m) _Pragma("unroll") for (int n = 0; n < 2; ++n) _Pragma("unroll") for (int k = 0; k < 2; ++k) \
        acc[ai][bj][m][n] = __builtin_amdgcn_mfma_f32_16x16x32_bf16(Bt[n][k], At[m][k], acc[ai][bj][m][n], 0, 0, 0); __builtin_amdgcn_s_setprio(0); } while (0)
#define PG8_WAIT_V(n) asm volatile("s_waitcnt vmcnt(" #n ")" ::: "memory")
#define PG8_WAIT_L(n) asm volatile("s_waitcnt lgkmcnt(" #n ")" ::: "memory")
#define PG8_BAR __builtin_amdgcn_s_barrier()
#define PG8_SCHED __builtin_amdgcn_sched_barrier(0)
    Unit cur, nxt; int ui = 0;
    if (!S.next(0, cur)) return;
    f32x4 acc[2][2][4][2];
#pragma unroll
    for (int a = 0; a < 2; ++a)
#pragma unroll
        for (int b = 0; b < 2; ++b)
#pragma unroll
            for (int m = 0; m < 4; ++m)
#pragma unroll
                for (int n = 0; n < 2; ++n) acc[a][b][m][n] = (f32x4){0.f, 0.f, 0.f, 0.f};
    bf16x8 At[4][2], B0[2][2], B1[2][2];
    const char* cA = (const char*)g.A + (GA ? (size_t)0 : (size_t)cur.pm * tstep); const char* cB = (const char*)g.Bt + (size_t)cur.pn * tstep;
    if constexpr (GA) PG8_GOFF(gC, cur);
    S.a_ready(cur);
    static_assert(SP2 || !GA, "gathered A rows: SP2 loop only");
    if constexpr (SP2) {
        PG8_STAGE(PG8_SB(0, 0), cB, voffB); PG8_STAGE(PG8_SB(0, 1), cB + hstep, voffB); PG8_STAGE_A(PG8_SA(0, 0), 0, cA, false); PG8_STAGE_A(PG8_SA(0, 1), 1, cA, false);
        if (wr == 1) PG8_BAR;
        PG8_WAIT_V(2); PG8_BAR;
        PG8_STAGE(PG8_SB(1, 0), cB + kstep, voffB); PG8_STAGE_A(PG8_SA(1, 0), 0, cA + kstep, false); PG8_STAGE(PG8_SB(1, 1), cB + hstep + kstep, voffB);
        PG8_WAIT_V(6); PG8_BAR;
    } else {
        PG8_STAGE(PG8_SB(0, 0), cB, voffB); PG8_STAGE(PG8_SA(0, 0), cA, voffA); PG8_STAGE(PG8_SB(0, 1), cB + hstep, voffB); PG8_STAGE(PG8_SA(0, 1), cA + hstep, voffA);
        if (wr == 1) PG8_BAR;
        PG8_WAIT_V(4); PG8_BAR;
        PG8_STAGE(PG8_SB(1, 0), cB + kstep, voffB); PG8_STAGE(PG8_SA(1, 0), cA + kstep, voffA); PG8_STAGE(PG8_SB(1, 1), cB + hstep + kstep, voffB);
        PG8_WAIT_V(6); PG8_BAR;
    }
    for (;;) {
        const bool has_next = S.next(ui + 1, nxt);
        const char* nA = (has_next && !GA) ? (const char*)g.A + (size_t)nxt.pm * tstep : cA; if constexpr (GA) { if (has_next) PG8_GOFF(gN, nxt); }
        const char* nB = has_next ? (const char*)g.Bt + (size_t)nxt.pn * tstep : cB;
        _Pragma("unroll 1") for (int t = 0; t < nt; t += 2) {
            const bool last = (t == nt - 2);
            const char* a1 = cA + (size_t)(t + 1) * kstep;
            const char* a2 = last ? nA : cA + (size_t)(t + 2) * kstep; const char* b2 = last ? nB : cB + (size_t)(t + 2) * kstep;
            const char* a3 = a2 + kstep; const char* b3 = b2 + kstep;
            if (last && has_next) S.a_ready(nxt);
            if constexpr (SP2) {
            PG8_LDB(B0, 0, 0); PG8_LDB(B1, 0, 1); PG8_SCHED; PG8_LDA(At, 0, 0); PG8_STAGE_A(PG8_SA(1, 1), 1, a1, false);
            PG8_WAIT_V(8); PG8_WAIT_L(0); PG8_BAR; PG8_MMA(0, 0, At, B0); PG8_MMA(0, 1, At, B1); PG8_BAR; PG8_SCHED;
            PG8_LDA(At, 0, 1); PG8_STAGE(PG8_SB(0, 0), b2, voffB); PG8_STAGE(PG8_SB(0, 1), b2 + hstep, voffB); PG8_STAGE_A(PG8_SA(0, 0), 0, a2, last && has_next);
            PG8_WAIT_V(8); PG8_WAIT_L(0); PG8_BAR; PG8_MMA(1, 0, At, B0); PG8_MMA(1, 1, At, B1); PG8_BAR; PG8_SCHED;
            PG8_LDB(B0, 1, 0); PG8_LDB(B1, 1, 1); PG8_SCHED; PG8_LDA(At, 1, 0); PG8_STAGE_A(PG8_SA(0, 1), 1, a2, last && has_next);
            PG8_WAIT_V(8); PG8_WAIT_L(0); PG8_BAR; PG8_MMA(0, 0, At, B0); PG8_MMA(0, 1, At, B1); PG8_BAR; PG8_SCHED;
            PG8_LDA(At, 1, 1); PG8_STAGE(PG8_SB(1, 0), b3, voffB); PG8_STAGE(PG8_SB(1, 1), b3 + hstep, voffB); PG8_STAGE_A(PG8_SA(1, 0), 0, a3, last && has_next);
            PG8_WAIT_V(8); PG8_WAIT_L(0); PG8_BAR; PG8_MMA(1, 0, At, B0); PG8_MMA(1, 1, At, B1); PG8_BAR; PG8_SCHED;
            } else {
            PG8_LDB(B0, 0, 0); PG8_SCHED; PG8_LDA(At, 0, 0); PG8_STAGE(PG8_SA(1, 1), a1 + hstep, voffA);
            PG8_WAIT_L(8); PG8_BAR; PG8_WAIT_L(0); PG8_MMA(0, 0, At, B0); PG8_BAR; PG8_SCHED;
            PG8_LDB(B1, 0, 1); PG8_STAGE(PG8_SB(0, 0), b2, voffB);
            PG8_BAR; PG8_WAIT_L(0); PG8_MMA(0, 1, At, B1); PG8_BAR;
            PG8_LDA(At, 0, 1); PG8_STAGE(PG8_SA(0, 0), a2, voffA);
            PG8_BAR; PG8_WAIT_L(0); PG8_MMA(1, 0, At, B0); PG8_BAR; PG8_SCHED;
            PG8_STAGE(PG8_SB(0, 1), b2 + hstep, voffB);
            PG8_WAIT_V(6); PG8_BAR; PG8_MMA(1, 1, At, B1); PG8_BAR;
            PG8_LDB(B0, 1, 0); PG8_SCHED; PG8_LDA(At, 1, 0); PG8_STAGE(PG8_SA(0, 1), a2 + hstep, voffA);
            PG8_WAIT_L(8); PG8_BAR; PG8_WAIT_L(0); PG8_MMA(0, 0, At, B0); PG8_BAR; PG8_SCHED;
            PG8_LDB(B1, 1, 1); PG8_STAGE(PG8_SB(1, 0), b3, voffB);
            PG8_BAR; PG8_WAIT_L(0); PG8_MMA(0, 1, At, B1); PG8_BAR;
            PG8_LDA(At, 1, 1); PG8_STAGE(PG8_SA(1, 0), a3, voffA);
            PG8_BAR; PG8_WAIT_L(0); PG8_MMA(1, 0, At, B0); PG8_BAR; PG8_SCHED;
            PG8_STAGE(PG8_SB(1, 1), b3 + hstep, voffB);
            PG8_WAIT_V(6); PG8_BAR; PG8_MMA(1, 1, At, B1); PG8_BAR;
            }
        }
        if constexpr (ALIGN_EPI) { if (wr == 0) PG8_BAR; }
        bool kept = false;
        if constexpr (!Epi::AFTER_DRAIN) {
            if constexpr (Epi::MID) { if (E.is_mid(cur)) { E.mid(acc, cur, wr, wc, fr, fq); kept = true; } else E(acc, cur, wr, wc, fr, fq); }
            else E(acc, cur, wr, wc, fr, fq);
            S.done(cur); }
        if (!has_next) break;
        if (!kept)
#pragma unroll
        for (int a = 0; a < 2; ++a)
#pragma unroll
            for (int b = 0; b < 2; ++b)
#pragma unroll
                for (int m = 0; m < 4; ++m)
#pragma unroll
                    for (int n = 0; n < 2; ++n) acc[a][b][m][n] = (f32x4){0.f, 0.f, 0.f, 0.f};
        cur = nxt; cA = nA; cB = nB; ++ui;
        if constexpr (GA) { _Pragma("unroll") for (int h_ = 0; h_ < 2; ++h_) _Pragma("unroll") for (int i_ = 0; i_ < 2; ++i_) gC[h_][i_] = gN[h_][i_]; }
        if constexpr (ALIGN_EPI) { if (wr == 1) PG8_BAR; }
    }
    PG8_WAIT_V(0);
    if constexpr (!ALIGN_EPI) { if (wr == 0) PG8_BAR; }
    PG8_BAR;
    if constexpr (Epi::AFTER_DRAIN) { E.fused(acc, cur, wr, wc, fr, fq, lds, wid, lane); S.done(cur); }
#undef PG8_SA
#undef PG8_GOFF
#undef PG8_STAGE_A
#undef PG8_SB
#undef PG8_STAGE
#undef PG8_LDA
#undef PG8_LDB
#undef PG8_MMA
#undef PG8_WAIT_V
#undef PG8_WAIT_L
#undef PG8_BAR
#undef PG8_SCHED
}
}
#define GAS __attribute__((address_space(1)))
#define LAS __attribute__((address_space(3)))
typedef unsigned short bf16;
typedef unsigned v4u __attribute__((ext_vector_type(4)));
typedef float f32x4 __attribute__((ext_vector_type(4)));
typedef short bf16x8 __attribute__((ext_vector_type(8)));
typedef GAS unsigned gu32;
typedef GAS unsigned long long gu64;
#define RLX_AGENT __ATOMIC_RELAXED, __HIP_MEMORY_SCOPE_AGENT
#define LDS_WAIT() asm volatile("s_waitcnt lgkmcnt(0)" ::: "memory")
#define VM_WAIT() asm volatile("s_waitcnt vmcnt(0)" ::: "memory")
__device__ __forceinline__ unsigned long long rt() { return __builtin_amdgcn_s_memrealtime(); }
__device__ __forceinline__ unsigned f2bf(float f) { unsigned u = __builtin_bit_cast(unsigned, f); return (u + 0x7fffu + ((u >> 16) & 1u)) >> 16; }
__device__ __forceinline__ unsigned pk2(float lo, float hi) { return f2bf(lo) | (f2bf(hi) << 16); }
#define XB_TMO      128
#define XB_XCNT(j)  (256  + 64 * (j))
#define XB_XSUB(j)  (1280 + 64 * (j))
#define XB_XGEN(j)  (2304 + 64 * (j))
#define XB_TOP      3328
#define XB_TOPGEN   3392
#define XCD_BAR_WORDS 3456
#define XB_SPIN_CAP (1u << 18)

__device__ __forceinline__ unsigned xb_ld(unsigned* p)              { return __hip_atomic_load(p, __ATOMIC_RELAXED, __HIP_MEMORY_SCOPE_AGENT); }
__device__ __forceinline__ unsigned xb_add(unsigned* p, unsigned v) { return __hip_atomic_fetch_add(p, v, __ATOMIC_RELAXED, __HIP_MEMORY_SCOPE_AGENT); }
__device__ __forceinline__ unsigned xb_xcc_id() { return (unsigned)__builtin_amdgcn_s_getreg((3 << 11) | 20) & 0xFu; }
#define XB_SPIN(cond, bar) do { unsigned _sp = 0; while (cond) { __builtin_amdgcn_s_sleep(1); \
    if ((++_sp & 255u) == 0u) { if (xb_ld(&(bar)[XB_TMO])) break; if (_sp > XB_SPIN_CAP) { atomicAdd(&(bar)[XB_TMO], 1u); break; } } } } while (0)

struct XcdBarrier {
    unsigned* bar; unsigned x;
    volatile LAS unsigned* st;
};

__device__ __forceinline__ XcdBarrier xcd_barrier_post(unsigned* bar, volatile LAS unsigned* st) {
    XcdBarrier b; b.bar = bar; b.x = xb_xcc_id(); b.st = st;
    if (threadIdx.x == 0) (void)xb_add(&bar[XB_XCNT(b.x)], 1u);
    return b;
}
__device__ __forceinline__ void xcd_barrier_complete(unsigned* bar, unsigned x, unsigned& nloc, unsigned& nx) {
    const unsigned G = gridDim.x * gridDim.y * gridDim.z;
    unsigned sum, cnt, mine, sp = 0u;
    for (;;) {
        sum = 0u; cnt = 0u; mine = 0u;
#pragma unroll
        for (unsigned j = 0; j < 16; ++j) { const unsigned c = xb_ld(&bar[XB_XCNT(j)]); sum += c; cnt += (c > 0u) ? 1u : 0u; mine = (j == x) ? c : mine; }
        if (sum == G) break;
        __builtin_amdgcn_s_sleep(1);
        if ((++sp & 255u) == 0u) { if (xb_ld(&bar[XB_TMO])) break; if (sp > XB_SPIN_CAP) { atomicAdd(&bar[XB_TMO], 1u); break; } }
    }
    nloc = mine > 0u ? mine : 1u; nx = cnt > 0u ? cnt : 1u;
}

__device__ __forceinline__ void xcd_barrier(const XcdBarrier& b) {
    asm volatile("s_waitcnt vmcnt(0)" ::: "memory");
    __syncthreads();
    if (threadIdx.x == 0) {
        unsigned* bar = b.bar;
        __builtin_amdgcn_s_waitcnt(0);
        unsigned nloc = b.st[0], nx = b.st[1];
        if (nloc == 0u) { xcd_barrier_complete(bar, b.x, nloc, nx); b.st[0] = nloc; b.st[1] = nx; }
        const unsigned old = xb_add(&bar[XB_XSUB(b.x)], 1u);
        const unsigned gen = old / nloc;
        if (old + 1u == (gen + 1u) * nloc) {
            __builtin_amdgcn_fence(__ATOMIC_RELEASE, "agent");
            asm volatile("s_waitcnt vmcnt(0)" ::: "memory");
            const unsigned og = xb_add(&bar[XB_TOP], 1u);
            const unsigned tg = og / nx;
            if (og + 1u == (tg + 1u) * nx) xb_add(&bar[XB_TOPGEN], 1u);
            else XB_SPIN(xb_ld(&bar[XB_TOPGEN]) == tg, bar);
            __builtin_amdgcn_fence(__ATOMIC_ACQUIRE, "agent");
            xb_add(&bar[XB_XGEN(b.x)], 1u);
            asm volatile("s_waitcnt vmcnt(0)" ::: "memory");
        } else {
            XB_SPIN(xb_ld(&bar[XB_XGEN(b.x)]) == gen, bar);
            __builtin_amdgcn_fence(__ATOMIC_ACQUIRE, "agent");
            asm volatile("s_waitcnt vmcnt(0)" ::: "memory");
        }
    }
    __syncthreads();
}
#ifndef NBF
#define NBF 8
#endif
namespace fx {
constexpr int NWAVES = 8, NTHR = 512;
constexpr int SEQ = 4096, DM = 1024, TT = NBF * SEQ;
constexpr int NPROJ = 4096;
constexpr int MOE_TILES = TT * 2 / 256 + 32, MOE_ROWS = MOE_TILES * 256;
constexpr float LOG2E = 1.4426950408889634f;
constexpr float C2A = 0.10206207261596577f * LOG2E;
constexpr float C2B = 0.125f * LOG2E;
constexpr float EPS = 1e-6f;

constexpr size_t MiB = 1u << 20;
constexpr size_t al(size_t x) { return (x + 4095) & ~(size_t)4095; }
constexpr size_t WS_CTL = 0, CTL_ZERO_BYTES = 1 * MiB;
constexpr int CW_BAR = 4096;
constexpr size_t CTL_MOD = 65536;
constexpr size_t CTL_CNT = 524288;
constexpr size_t WS_WIN = 2 * MiB;
constexpr size_t WS_WUQ = 10 * MiB;
constexpr size_t WS_WKV = 10 * MiB + 512 * 1024;
constexpr size_t WS_WOAB = 11 * MiB;
constexpr size_t WS_WOUT = 13 * MiB;
constexpr size_t WS_WGU = 16 * MiB;
constexpr size_t WS_WD = 48 * MiB;
constexpr size_t WS_CS = 64 * MiB;
constexpr size_t WS_RT = WS_CS + al((size_t)TT * 16 * 8);
constexpr size_t RT_ARR = al((size_t)TT * 2 * 4);
constexpr size_t WS_RT_E = WS_RT, WS_RT_RANK = WS_RT + RT_ARR, WS_RT_W = WS_RT + 2 * RT_ARR, WS_RT_POS = WS_RT + 3 * RT_ARR;
constexpr size_t WS_RT_RINV = WS_RT + 4 * RT_ARR;
constexpr size_t WS_WROW = WS_RT + 5 * RT_ARR;
constexpr size_t WS_LIST = al(WS_WROW + (size_t)MOE_ROWS * 4);
constexpr size_t WS_MODP = al(WS_LIST + (size_t)MOE_ROWS * 4);
constexpr size_t WS_SSQ_Q = WS_MODP + 3 * MiB, WS_SSQ_KV = WS_SSQ_Q + (size_t)TT * 16;
constexpr size_t WS_SSQ_X = WS_SSQ_KV + (size_t)TT * 16;
constexpr size_t WS_ACT = al(WS_SSQ_X + (size_t)TT * 64);
constexpr size_t SZ_H = (size_t)TT * 1024 * 2;
constexpr size_t WS_H = WS_ACT;
constexpr size_t WS_QLAT = WS_H + SZ_H;
constexpr size_t WS_KVL = WS_QLAT + SZ_H / 4;
constexpr size_t WS_QB = WS_KVL + SZ_H / 4, WS_KB = WS_QB + SZ_H / 2, WS_VB = WS_KB + SZ_H / 2;
constexpr size_t WS_QA = WS_VB + SZ_H / 2;
constexpr size_t WS_KN = WS_QA + SZ_H * 3 / 4, WS_VA = WS_KN + SZ_H / 2;
constexpr size_t WS_KR = WS_VA + SZ_H / 2;
constexpr size_t WS_OAB = WS_KR + SZ_H / 32;
constexpr size_t WS_MERGED = WS_OAB + SZ_H;
constexpr size_t WS_END1 = WS_MERGED + SZ_H;
constexpr size_t WS_ELIST = WS_QLAT;
constexpr size_t WS_EWT = WS_ELIST + (size_t)32 * TT * 4;
constexpr size_t WS_HID = WS_EWT + (size_t)32 * TT * 4;
constexpr size_t WS_YB = WS_HID + (size_t)MOE_ROWS * 512;
constexpr size_t WS_END2 = WS_YB + (size_t)MOE_ROWS * 2048;
constexpr size_t WS_FAST_END = WS_END1 > WS_END2 ? WS_END1 : WS_END2;
static_assert(NBF != 8 || WS_FAST_END <= 512 * MiB, "workspace map exceeds 512 MiB");
static_assert(CTL_CNT + 32 * 256 <= CTL_ZERO_BYTES && (CW_BAR + 3 * 3456) * 4 <= (int)CTL_MOD, "ctl map");

constexpr int LDS_BYTES = 163840;
constexpr int RING_OFF = 0;
constexpr int P7S_OFF = 149504;
constexpr int LCTL_OFF = 159744;
static_assert(P7S_OFF + 8192 <= LCTL_OFF, "lds map");

struct Params {
    const float *x, *c; const int* pos;
    const float *w_ada, *b_ada, *g_mix, *w_in, *g_q, *w_uq, *g_kv, *w_uk, *w_uv, *rel, *w_oa, *w_ob, *w_out, *g_ffn, *w_rg, *b_rg, *w_re, *b_re, *w_gate, *w_up, *w_down, *g_final;
    float* out;
    unsigned char* ws;
    int ph_lo, ph_hi;
    int li, pad;
};
typedef const __attribute__((address_space(4))) Params* KP;
}
namespace fx {
using pg8::Unit; using pg8::bf16_t;
typedef float f32x2_t __attribute__((ext_vector_type(2)));
typedef __bf16 bf16x2_t __attribute__((ext_vector_type(2)));
typedef float f32x16 __attribute__((ext_vector_type(16)));
typedef short v4i16_t __attribute__((ext_vector_type(4)));
typedef unsigned u32x2 __attribute__((ext_vector_type(2)));
typedef unsigned u32x4 __attribute__((ext_vector_type(4)));

__device__ __forceinline__ unsigned cvtpk(float lo, float hi) { f32x2_t v = {lo, hi}; bf16x2_t b = __builtin_convertvector(v, bf16x2_t); return __builtin_bit_cast(unsigned, b); }
__device__ __forceinline__ float bf_lo(unsigned u) { return __builtin_bit_cast(float, u << 16); }
__device__ __forceinline__ float bf_hi(unsigned u) { return __builtin_bit_cast(float, u & 0xffff0000u); }
template <int CTRL, int ROWMASK> __device__ __forceinline__ float dpp_add(float v) {
    const int t = __builtin_amdgcn_update_dpp(0, __builtin_bit_cast(int, v), CTRL, ROWMASK, 0xF, false);
    return v + __builtin_bit_cast(float, t);
}
__device__ __forceinline__ float wave_sum(float v) {
    v = dpp_add<0xB1, 0xF>(v); v = dpp_add<0x4E, 0xF>(v); v = dpp_add<0x141, 0xF>(v); v = dpp_add<0x140, 0xF>(v);
    v = dpp_add<0x142, 0xA>(v); v = dpp_add<0x143, 0xC>(v);
    return __builtin_bit_cast(float, __builtin_amdgcn_readlane(__builtin_bit_cast(int, v), 63));
}
__device__ __forceinline__ float fsigmoid(float v) { return __builtin_amdgcn_rcpf(1.0f + __builtin_amdgcn_exp2f(-v * LOG2E)); }
__device__ __forceinline__ u32x4 pack8(const f32x4& a, const f32x4& b) { u32x4 w; w.x = cvtpk(a[0], a[1]); w.y = cvtpk(a[2], a[3]); w.z = cvtpk(b[0], b[1]); w.w = cvtpk(b[2], b[3]); return w; }

struct Frame {
    LAS unsigned char* lds;
    gu32* ctl;
    int tid, lane, wave, vcu, G;
};

struct EpiProj {
    static constexpr bool PERM = true, AFTER_DRAIN = false, MID = false;
    bf16_t *qlat, *kvl, *qb, *kb, *vb, *ga, *gb; float *ssq_q, *ssq_kv;
    __device__ __forceinline__ void operator()(const f32x4 (&acc)[2][2][4][2], const Unit& u, int wr, int wc, int fr, int fq) const {
        const int pn = u.pn;
        bf16_t* base; int ld, ct, mode = 0;
        float* ssqp = nullptr;
        if (pn == 0) { base = qlat; ld = 256; ct = 0; mode = 3; ssqp = ssq_q; }
        else if (pn == 1) { base = kvl; ld = 256; ct = 0; mode = 4; ssqp = ssq_kv; }
        else if (pn < 4) { base = qb; ld = 512; ct = (pn - 2) * 256; mode = 1; }
        else if (pn < 6) { base = kb; ld = 512; ct = (pn - 4) * 256; }
        else if (pn < 8) { base = vb; ld = 512; ct = (pn - 6) * 256; }
        else if (pn < 12) { base = ga; ld = 1024; ct = (pn - 8) * 256; mode = 2; }
        else { base = gb; ld = 1024; ct = (pn - 12) * 256; mode = 2; }
        const int row0 = u.pm * 256 + wr * 64 + fr, col0 = ct + wc * 32 + 8 * fq;
#pragma unroll
        for (int ai = 0; ai < 2; ++ai)
#pragma unroll
            for (int m = 0; m < 4; ++m) {
                const int row = row0 + ai * 128 + m * 16;
                bf16_t* rowp = base + (size_t)row * ld + col0;
                float ss0 = 0.f, ss1 = 0.f;
#pragma unroll
                for (int bj = 0; bj < 2; ++bj) {
                    f32x4 v0 = acc[ai][bj][m][0], v1 = acc[ai][bj][m][1];
                    if (mode == 1) { v0 = v0 * C2B; v1 = v1 * C2B; }
                    if (mode == 2) {
#pragma unroll
                        for (int e = 0; e < 4; ++e) { v0[e] = fsigmoid(v0[e]); v1[e] = fsigmoid(v1[e]); } }
                    const float s = (v0[0] * v0[0] + v0[1] * v0[1]) + (v0[2] * v0[2] + v0[3] * v0[3]) + (v1[0] * v1[0] + v1[1] * v1[1]) + (v1[2] * v1[2] + v1[3] * v1[3]);
                    if (bj == 0) ss0 = s; else ss1 = s;
                    *(u32x4*)(rowp + bj * 128) = pack8(v0, v1);
                }
                if (mode >= 3) {
                    float s = (mode == 3) ? ss0 + ss1 : ss0;
                    s += __shfl_xor(s, 16); s += __shfl_xor(s, 32);
                    if (fq == 0) ssqp[row * 4 + wc] = s;
                }
            }
    }
};
struct EpiQA {
    static constexpr bool PERM = true, AFTER_DRAIN = false, MID = false;
    bf16_t* qa; const float* ssq_q; const float* cs;
    __device__ __forceinline__ void operator()(const f32x4 (&acc)[2][2][4][2], const Unit& u, int wr, int wc, int fr, int fq) const {
        const int pn = u.pn, row0 = u.pm * 256 + wr * 64 + fr, col0 = pn * 256 + wc * 32 + 8 * fq;
        f32x4 sp[2][4];
#pragma unroll
        for (int ai = 0; ai < 2; ++ai)
#pragma unroll
            for (int m = 0; m < 4; ++m) sp[ai][m] = *(const f32x4*)(ssq_q + (size_t)(row0 + ai * 128 + m * 16) * 4);
#pragma unroll
        for (int ah = 0; ah < 4; ++ah) {
            const int ai = ah >> 1; f32x4 cq[2][4];
            if (pn == 2) {
#pragma unroll
                for (int mm = 0; mm < 2; ++mm) { const f32x4* csr = (const f32x4*)(cs + (size_t)(row0 + ai * 128 + ((ah & 1) * 2 + mm) * 16) * 32 + 16 * (fq & 1));
#pragma unroll
                    for (int j = 0; j < 4; ++j) cq[mm][j] = csr[j]; } }
#pragma unroll
            for (int mm = 0; mm < 2; ++mm) {
                const int m = (ah & 1) * 2 + mm, row = row0 + ai * 128 + m * 16;
                const float sc = C2A / sqrtf(((sp[ai][m][0] + sp[ai][m][1]) + (sp[ai][m][2] + sp[ai][m][3])) * (1.f / 256.f) + EPS);
                bf16_t* rowp = qa + (size_t)row * 768 + col0;
                if (pn < 2) {
#pragma unroll
                    for (int bj = 0; bj < 2; ++bj) *(u32x4*)(rowp + bj * 128) = pack8(acc[ai][bj][m][0] * sc, acc[ai][bj][m][1] * sc);
                } else {
                    const float cc[8] = {cq[mm][0][0], cq[mm][0][2], cq[mm][1][0], cq[mm][1][2], cq[mm][2][0], cq[mm][2][2], cq[mm][3][0], cq[mm][3][2]};
                    const float sn[8] = {cq[mm][0][1], cq[mm][0][3], cq[mm][1][1], cq[mm][1][3], cq[mm][2][1], cq[mm][2][3], cq[mm][3][1], cq[mm][3][3]};
                    const float sgn = (fq < 2) ? -1.f : 1.f;
#pragma unroll
                    for (int bj = 0; bj < 2; ++bj) {
                        f32x4 o[2];
#pragma unroll
                        for (int n = 0; n < 2; ++n)
#pragma unroll
                            for (int e = 0; e < 4; ++e) { const float v = acc[ai][bj][m][n][e] * sc; const float p = __shfl_xor(v, 32); o[n][e] = v * cc[4 * n + e] + sgn * p * sn[4 * n + e]; }
                        *(u32x4*)(rowp + bj * 128) = pack8(o[0], o[1]);
                    }
                }
            }
        }
    }
};
struct EpiKV {
    static constexpr bool PERM = true, AFTER_DRAIN = false, MID = false;
    bf16_t *kn, *va; const float* ssq_kv;
    __device__ __forceinline__ void operator()(const f32x4 (&acc)[2][2][4][2], const Unit& u, int wr, int wc, int fr, int fq) const {
        const int pn = u.pn, row0 = u.pm * 256 + wr * 64 + fr, col0 = (pn & 1) * 256 + wc * 32 + 8 * fq;
        bf16_t* base = pn < 2 ? kn : va;
        f32x4 spv[2][4];
#pragma unroll
        for (int ai = 0; ai < 2; ++ai)
#pragma unroll
            for (int m = 0; m < 4; ++m) spv[ai][m] = *(const f32x4*)(ssq_kv + (size_t)(row0 + ai * 128 + m * 16) * 4);
#pragma unroll
        for (int ai = 0; ai < 2; ++ai)
#pragma unroll
            for (int m = 0; m < 4; ++m) {
                const int row = row0 + ai * 128 + m * 16;
                const f32x4 sp = spv[ai][m]; const float sc = 1.0f / sqrtf(((sp[0] + sp[1]) + (sp[2] + sp[3])) * (1.f / 128.f) + EPS);
                bf16_t* rowp = base + (size_t)row * 512 + col0;
#pragma unroll
                for (int bj = 0; bj < 2; ++bj) *(u32x4*)(rowp + bj * 128) = pack8(acc[ai][bj][m][0] * sc, acc[ai][bj][m][1] * sc);
            }
    }
};
struct EpiMerge {
    static constexpr bool PERM = true, AFTER_DRAIN = false, MID = true;
    bf16_t* merged; const bf16_t *ga, *gb;
    __device__ __forceinline__ bool is_mid(const Unit& u) const { return u.pn < 4; }
    __device__ __forceinline__ void mid(f32x4 (&acc)[2][2][4][2], const Unit& u, int wr, int wc, int fr, int fq) const {
        const int row0 = u.pm * 256 + wr * 64 + fr, col0 = u.pn * 256 + wc * 32 + 8 * fq;
#pragma unroll
        for (int ai = 0; ai < 2; ++ai) {
            u32x4 av[4][2], bv[4][2];
#pragma unroll
            for (int m = 0; m < 4; ++m)
#pragma unroll
                for (int bj = 0; bj < 2; ++bj) { const size_t off = (size_t)(row0 + ai * 128 + m * 16) * 1024 + col0 + bj * 128; av[m][bj] = *(const u32x4*)(ga + off); bv[m][bj] = *(const u32x4*)(gb + off); }
#pragma unroll
            for (int m = 0; m < 4; ++m)
#pragma unroll
                for (int bj = 0; bj < 2; ++bj) {
                    const u32x4 a = av[m][bj], c = bv[m][bj];
                    const float sa[8] = {bf_lo(a.x), bf_hi(a.x), bf_lo(a.y), bf_hi(a.y), bf_lo(a.z), bf_hi(a.z), bf_lo(a.w), bf_hi(a.w)};
                    const float sb[8] = {bf_lo(c.x), bf_hi(c.x), bf_lo(c.y), bf_hi(c.y), bf_lo(c.z), bf_hi(c.z), bf_lo(c.w), bf_hi(c.w)};
#pragma unroll
                    for (int e = 0; e < 4; ++e) { acc[ai][bj][m][0][e] *= sa[e] * __builtin_amdgcn_rcpf(fmaxf(sb[e], 1e-12f)); acc[ai][bj][m][1][e] *= sa[4 + e] * __builtin_amdgcn_rcpf(fmaxf(sb[4 + e], 1e-12f)); }
                }
        }
    }
    __device__ __forceinline__ void operator()(const f32x4 (&acc)[2][2][4][2], const Unit& u, int wr, int wc, int fr, int fq) const {
        const int pn = u.pn & 3, pm = u.pm - TT / 256;
        const int row0 = pm * 256 + wr * 64 + fr, col0 = pn * 256 + wc * 32 + 8 * fq;
#pragma unroll
        for (int ai = 0; ai < 2; ++ai) {
            u32x4 bv[4][2];
#pragma unroll
            for (int m = 0; m < 4; ++m)
#pragma unroll
                for (int bj = 0; bj < 2; ++bj) bv[m][bj] = *(const u32x4*)(gb + (size_t)(row0 + ai * 128 + m * 16) * 1024 + col0 + bj * 128);
#pragma unroll
            for (int m = 0; m < 4; ++m)
#pragma unroll
                for (int bj = 0; bj < 2; ++bj) {
                    const u32x4 c = bv[m][bj];
                    const float sb[8] = {bf_lo(c.x), bf_hi(c.x), bf_lo(c.y), bf_hi(c.y), bf_lo(c.z), bf_hi(c.z), bf_lo(c.w), bf_hi(c.w)};
                    f32x4 v0 = acc[ai][bj][m][0], v1 = acc[ai][bj][m][1];
#pragma unroll
                    for (int e = 0; e < 4; ++e) { v0[e] *= fmaxf(sb[e], 1e-12f); v1[e] *= fmaxf(sb[4 + e], 1e-12f); }
                    *(u32x4*)(merged + (size_t)(row0 + ai * 128 + m * 16) * 1024 + col0 + bj * 128) = pack8(v0, v1);
                }
        }
    }
};
struct EpiResid {
    static constexpr bool PERM = false, AFTER_DRAIN = false, MID = false;
    const float* x; float* x1; const float* mod; float* ssqx;
    __device__ __forceinline__ void operator()(const f32x4 (&acc)[2][2][4][2], const Unit& u, int wr, int wc, int fr, int fq) const {
        const int row0 = u.pm * 256 + wr * 64 + fr, col0 = u.pn * 256 + wc * 32 + 4 * fq;
        const float* gt = mod + (size_t)(u.pm / 16) * 6144 + 2048;
        f32x4 gv[2][2];
#pragma unroll
        for (int bj = 0; bj < 2; ++bj)
#pragma unroll
            for (int n = 0; n < 2; ++n) gv[bj][n] = *(const f32x4*)(gt + col0 + bj * 128 + n * 16);
#pragma unroll
        for (int ai = 0; ai < 2; ++ai) {
            f32x4 xv[4][2][2];
#pragma unroll
            for (int m = 0; m < 4; ++m) { const size_t off = (size_t)(row0 + ai * 128 + m * 16) * 1024 + col0;
#pragma unroll
                for (int bj = 0; bj < 2; ++bj)
#pragma unroll
                    for (int n = 0; n < 2; ++n) xv[m][bj][n] = *(const f32x4*)(x + off + bj * 128 + n * 16); }
#pragma unroll
            for (int m = 0; m < 4; ++m) { const size_t off = (size_t)(row0 + ai * 128 + m * 16) * 1024 + col0;
#pragma unroll
                for (int bj = 0; bj < 2; ++bj)
#pragma unroll
                    for (int n = 0; n < 2; ++n) { const f32x4 r = xv[m][bj][n] + gv[bj][n] * acc[ai][bj][m][n]; *(f32x4*)(x1 + off + bj * 128 + n * 16) = r; xv[m][bj][n] = r; } }
#pragma unroll
            for (int m = 0; m < 4; ++m) { float s = 0.f;
#pragma unroll
                for (int bj = 0; bj < 2; ++bj)
#pragma unroll
                    for (int n = 0; n < 2; ++n) { const f32x4 r = xv[m][bj][n]; s += (r[0] * r[0] + r[1] * r[1]) + (r[2] * r[2] + r[3] * r[3]); }
                s += __shfl_xor(s, 16); s += __shfl_xor(s, 32);
                if (fq == 0) ssqx[(size_t)(row0 + ai * 128 + m * 16) * 16 + u.pn * 4 + wc] = s; }
        }
    }
};
struct EpiGU {
    static constexpr bool PERM = true, AFTER_DRAIN = false, MID = false;
    bf16_t* hid; const float* ewt; const LAS int* tab; const LAS int* toff;
    __device__ __forceinline__ void operator()(const f32x4 (&acc)[2][2][4][2], const Unit& u, int wr, int wc, int fr, int fq) const {
        const int row0 = u.pm * 256 + wr * 64 + fr, col0 = (u.pn & 1) * 128 + wc * 32 + 8 * fq;
        float wv[2][4];
        const int e_ = __builtin_amdgcn_readfirstlane(tab[1 + u.pm]), base_ = __builtin_amdgcn_readfirstlane(toff[e_]) * 256, cnt_ = __builtin_amdgcn_readfirstlane(toff[40 + e_]);
#pragma unroll
        for (int ai = 0; ai < 2; ++ai)
#pragma unroll
            for (int m = 0; m < 4; ++m) { const int idx = row0 + ai * 128 + m * 16 - base_; wv[ai][m] = idx < cnt_ ? ewt[(size_t)e_ * TT + idx] : 0.f; }
#pragma unroll
        for (int ai = 0; ai < 2; ++ai)
#pragma unroll
            for (int m = 0; m < 4; ++m) {
                const int row = row0 + ai * 128 + m * 16; const float w = wv[ai][m];
                f32x4 o[2];
#pragma unroll
                for (int n = 0; n < 2; ++n)
#pragma unroll
                    for (int e = 0; e < 4; ++e) { const float a = acc[ai][0][m][n][e], uu = acc[ai][1][m][n][e]; o[n][e] = a * fsigmoid(a) * uu * w; }
                *(u32x4*)(hid + (size_t)row * 256 + col0) = pack8(o[0], o[1]);
            }
    }
};
struct EpiDown {
    static constexpr bool PERM = true, AFTER_DRAIN = false, MID = false;
    bf16_t* yb;
    __device__ __forceinline__ void operator()(const f32x4 (&acc)[2][2][4][2], const Unit& u, int wr, int wc, int fr, int fq) const {
        const int row0 = u.pm * 256 + wr * 64 + fr, col0 = (u.pn & 3) * 256 + wc * 32 + 8 * fq;
#pragma unroll
        for (int ai = 0; ai < 2; ++ai)
#pragma unroll
            for (int m = 0; m < 4; ++m) { bf16_t* rowp = yb + (size_t)(row0 + ai * 128 + m * 16) * 1024 + col0;
#pragma unroll
                for (int bj = 0; bj < 2; ++bj) *(u32x4*)(rowp + bj * 128) = pack8(acc[ai][bj][m][0], acc[ai][bj][m][1]); }
    }
};

struct PairOrder {
    static constexpr bool GATHER = false; __device__ __forceinline__ unsigned a_row_off(int) const { return 0u; }
    pg8::StaticOrder so;
    __device__ void init(int G, int c) { so.init(TT, 1024, G, c); }
    __device__ bool next(int i, Unit& u) const { if (!so.next(i >> 1, u)) return false; if (i & 1) { u.pm += TT / 256; u.pn += 4; } return true; }
    __device__ __forceinline__ void a_ready(const Unit&) const {}
    __device__ __forceinline__ void done(const Unit&) const {}
};
template <bool GATHER_> struct MoeOrderT {
    static constexpr bool GATHER = GATHER_; const int* elist; const LAS int* toff;
    __device__ __forceinline__ unsigned a_row_off(int r) const {
        const int e = __builtin_amdgcn_readfirstlane(tab[1 + (r >> 8)]), idx = r - __builtin_amdgcn_readfirstlane(toff[e]) * 256, cnt = __builtin_amdgcn_readfirstlane(toff[40 + e]);
        const int tok = elist[(size_t)e * TT + (idx < TT ? idx : TT - 1)]; return (unsigned)(idx < cnt ? tok : 0) * 2048u; }
    const LAS int* tab; int nct, G, c;
    __device__ bool next(int i, Unit& u) const {
        const int nrt = __builtin_amdgcn_readfirstlane(tab[0]); const long L = (long)i * G + c; if (L >= (long)nrt * nct) return false;
        const int rt = (int)(L / nct), ct = (int)(L % nct); u.pm = rt; u.pn = __builtin_amdgcn_readfirstlane(tab[1 + rt]) * nct + ct; return true;
    }
    __device__ __forceinline__ void a_ready(const Unit&) const {}
    __device__ __forceinline__ void done(const Unit&) const {}
};
typedef MoeOrderT<false> MoeOrder;
}
namespace fx {
typedef short bf16x8 __attribute__((ext_vector_type(8)));
__device__ __forceinline__ void tr_item(const float* W, int ldw, int k0, int n0, bf16_t* WT, int ldt, int drow0, const float* kscale, LAS float* scr, int lane) {
    float tv[32];
#pragma unroll
    for (int i = 0; i < 32; ++i) { const int kk = 2 * i + (lane >> 5); tv[i] = W[(size_t)(k0 + kk) * ldw + n0 + (lane & 31)]; }
#pragma unroll
    for (int i = 0; i < 32; ++i) { const int kk = 2 * i + (lane >> 5); float v = tv[i]; if (kscale) v *= kscale[k0 + kk]; scr[kk * 33 + (lane & 31)] = v; }
    LDS_WAIT(); asm volatile("" ::: "memory");
    const int c = lane & 7;
#pragma unroll
    for (int j = 0; j < 4; ++j) { const int n = (lane >> 3) + 8 * j; const LAS float* s = scr + (8 * c) * 33 + n;
        u32x4 o; o.x = cvtpk(s[0 * 33], s[1 * 33]); o.y = cvtpk(s[2 * 33], s[3 * 33]); o.z = cvtpk(s[4 * 33], s[5 * 33]); o.w = cvtpk(s[6 * 33], s[7 * 33]);
        *(u32x4*)(WT + (size_t)(drow0 + n) * ldt + k0 + 8 * c) = o; }
    LDS_WAIT(); asm volatile("" ::: "memory");
}
constexpr int N_DEFERRED = 2 * 256 + 512 + 32 * 384;
__device__ __forceinline__ void tr_deferred(KP P, int r, LAS float* scr, int lane) {
    unsigned char* ws = P->ws;
    bf16_t* WoabT = (bf16_t*)(ws + WS_WOAB); bf16_t* WoutT = (bf16_t*)(ws + WS_WOUT); bf16_t* WguT = (bf16_t*)(ws + WS_WGU); bf16_t* WdT = (bf16_t*)(ws + WS_WD);
    constexpr int I_OA = 8 * 32, I_OUT = 16 * 32, I_G = 16 * 8, I_D = 4 * 32, I_E = 2 * I_G + I_D;
    if (r < I_OA) { const int kb = r / 32, nb = r % 32; tr_item(P->w_oa, 1024, kb * 64, nb * 32, WoabT, 512, nb * 32, nullptr, scr, lane); return; } r -= I_OA;
    if (r < I_OA) { const int kb = r / 32, nb = r % 32; tr_item(P->w_ob, 1024, kb * 64, nb * 32, WoabT, 512, 1024 + nb * 32, nullptr, scr, lane); return; } r -= I_OA;
    if (r < I_OUT) { const int kb = r / 32, nb = r % 32; tr_item(P->w_out, 1024, kb * 64, nb * 32, WoutT, 1024, nb * 32, nullptr, scr, lane); return; } r -= I_OUT;
    const int e = r / I_E; r -= e * I_E;
    if (r < I_G) { const int kb = r / 8, nb = r % 8, n0 = nb * 32; tr_item(P->w_gate + (size_t)e * 262144, 256, kb * 64, n0, WguT, 1024, e * 512 + (n0 >> 7) * 256 + (n0 & 127), nullptr, scr, lane); return; } r -= I_G;
    if (r < I_G) { const int kb = r / 8, nb = r % 8, n0 = nb * 32; tr_item(P->w_up + (size_t)e * 262144, 256, kb * 64, n0, WguT, 1024, e * 512 + (n0 >> 7) * 256 + 128 + (n0 & 127), nullptr, scr, lane); return; } r -= I_G;
    { const int kb = r / 32, nb = r % 32; tr_item(P->w_down + (size_t)e * 262144, 1024, kb * 64, nb * 32, WdT, 256, e * 1024 + nb * 32, nullptr, scr, lane); }
}
__device__ __forceinline__ void p0_prologue(KP P, Frame& F) {
    unsigned char* ws = P->ws;
    LAS float* scr = (LAS float*)(F.lds + RING_OFF + F.wave * 16384);
    const int gw = F.vcu * NWAVES + F.wave, NGW = F.G * NWAVES, lane = F.lane;
    bf16_t* WinT = (bf16_t*)(ws + WS_WIN); bf16_t* WuqT = (bf16_t*)(ws + WS_WUQ); bf16_t* WkvT = (bf16_t*)(ws + WS_WKV);
    constexpr int I_IN = 16 * 125, I_UQ = 4 * 24, I_UK = 2 * 16;
    constexpr int NITEMS = I_IN + I_UQ + 2 * I_UK;
    for (int it = gw; it < NITEMS; it += NGW) {
        int r = it;
        if (r < I_IN) { const int kb = r / 125, nb = r % 125, n0 = nb * 32; tr_item(P->w_in, 4000, kb * 64, n0, WinT, 1024, n0 < 416 ? n0 : n0 + 96, nullptr, scr, lane); continue; } r -= I_IN;
        if (r < I_UQ) { const int kb = r / 24, nb = r % 24, n0 = nb * 32, h = n0 / 96, j = (n0 % 96) / 32; tr_item(P->w_uq, 768, kb * 64, n0, WuqT, 256, j < 2 ? h * 64 + 32 * j : 512 + 32 * h, P->g_q, scr, lane); continue; } r -= I_UQ;
        if (r < I_UK) { const int kb = r / 16, nb = r % 16; tr_item(P->w_uk, 512, kb * 64, nb * 32, WkvT, 256, nb * 32, P->g_kv, scr, lane); continue; } r -= I_UK;
        { const int kb = r / 16, nb = r % 16; tr_item(P->w_uv, 512, kb * 64, nb * 32, WkvT, 256, 512 + nb * 32, P->g_kv, scr, lane); }
    }
    const int gt = gw * 64 + lane, NGT = NGW * 64; const u32x4 z4 = {0u, 0u, 0u, 0u};
    for (int i = gt; i < 12288; i += NGT) *(u32x4*)(WinT + (size_t)416 * 1024 + (size_t)i * 8) = z4;
    for (int i = gt; i < 16384; i += NGT) *(u32x4*)(WkvT + (size_t)(i >> 4) * 256 + 128 + (i & 15) * 8) = z4;
    float* modp = (float*)(ws + WS_MODP);
    for (int it = gw; it < 96 * 16; it += NGW) {
        const int cg = it % 96, ks = it / 96, n = cg * 64 + lane, k0 = ks * 64;
#pragma unroll
        for (int b = 0; b < 8; ++b) { const float cv = P->c[b * 1024 + k0 + lane]; scr[b * 64 + lane] = cv / (1.f + __expf(-cv)); }
        LDS_WAIT(); asm volatile("" ::: "memory");
        float a[8];
#pragma unroll
        for (int b = 0; b < 8; ++b) a[b] = 0.f;
#pragma unroll 16
        for (int k = 0; k < 64; ++k) { const float w = P->w_ada[(size_t)(k0 + k) * 6144 + n];
#pragma unroll
            for (int b = 0; b < 8; ++b) a[b] += scr[b * 64 + k] * w; }
        const float bias = (ks == 0) ? P->b_ada[n] : 0.f;
#pragma unroll
        for (int b = 0; b < 8; ++b) modp[((size_t)ks * 8 + b) * 6144 + n] = a[b] + bias;
        LDS_WAIT(); asm volatile("" ::: "memory");
    }
    f32x2_t* cs = (f32x2_t*)(ws + WS_CS);
    for (int i = gt; i < TT * 16; i += NGT) { const int t = i >> 4, j = i & 15; const float ang = (float)P->pos[t] * powf(10000.0f, -(float)j * (1.f / 16.f)); f32x2_t v; v.x = cosf(ang); v.y = sinf(ang); cs[i] = v; }
}
__device__ __forceinline__ void p1_norm(KP P, Frame& F) {
    const int lane = F.lane, tid = F.tid, wid = F.wave;
    const float* modp = (const float*)(P->ws + WS_MODP); float* modf = (float*)(P->ws + CTL_MOD); bf16_t* H = (bf16_t*)(P->ws + WS_H);
    LAS float* modl = (LAS float*)(F.lds + RING_OFF);
    const int RPW = (TT + F.G - 1) / F.G, row_lo = F.vcu * RPW, b = row_lo / SEQ, wpb = SEQ / RPW, slice = 6144 / wpb, s0 = (F.vcu % wpb) * slice;
    for (int i = tid; i < 2048; i += NTHR) { float a = 0.f;
#pragma unroll
        for (int ks = 0; ks < 16; ++ks) a += modp[((size_t)ks * 8 + b) * 6144 + i];
        modl[i] = a; }
    for (int i = tid; i < slice; i += NTHR) { float a = 0.f;
#pragma unroll
        for (int ks = 0; ks < 16; ++ks) a += modp[((size_t)ks * 8 + b) * 6144 + s0 + i];
        modf[(size_t)b * 6144 + s0 + i] = a; }
    __syncthreads();
    const int rpwave = RPW / NWAVES;
    for (int it = 0; it < rpwave; it += 2) {
        const int m0 = row_lo + wid * rpwave + it;
        f32x4 v[2][4]; float ss[2];
#pragma unroll
        for (int rr = 0; rr < 2; ++rr) { const f32x4* xr = (const f32x4*)(P->x + (size_t)(m0 + rr) * 1024) + lane;
#pragma unroll
            for (int j = 0; j < 4; ++j) v[rr][j] = xr[64 * j]; }
#pragma unroll
        for (int rr = 0; rr < 2; ++rr) { float s = 0.f;
#pragma unroll
            for (int j = 0; j < 4; ++j) s += (v[rr][j][0] * v[rr][j][0] + v[rr][j][1] * v[rr][j][1]) + (v[rr][j][2] * v[rr][j][2] + v[rr][j][3] * v[rr][j][3]);
            ss[rr] = wave_sum(s); }
#pragma unroll
        for (int rr = 0; rr < 2; ++rr) {
            const float inv = 1.0f / sqrtf(ss[rr] * (1.f / 1024.f) + EPS);
            u32x2* o8 = (u32x2*)(H + (size_t)(m0 + rr) * 1024) + lane;
#pragma unroll
            for (int j = 0; j < 4; ++j) { const int col = 4 * lane + 256 * j;
                const f32x4 g = *(const f32x4*)(P->g_mix + col), s1 = *(const LAS f32x4*)(modl + 1024 + col), h1 = *(const LAS f32x4*)(modl + col);
                f32x4 y;
#pragma unroll
                for (int e = 0; e < 4; ++e) y[e] = v[rr][j][e] * inv * g[e] * (1.f + s1[e]) + h1[e];
                u32x2 w; w.x = cvtpk(y[0], y[1]); w.y = cvtpk(y[2], y[3]); o8[64 * j] = w; }
        }
    }
    __syncthreads();
}
__device__ __forceinline__ void p3_krope(KP P, Frame& F) {
    const int gt = (F.vcu * NWAVES + F.wave) * 64 + F.lane, NGT = F.G * NWAVES * 64;
    const bf16_t* kvl = (const bf16_t*)(P->ws + WS_KVL); bf16_t* kr = (bf16_t*)(P->ws + WS_KR); const f32x2_t* cs = (const f32x2_t*)(P->ws + WS_CS);
    for (int i = gt; i < TT * 16; i += NGT) { const int t = i >> 4, j = i & 15;
        const float x1 = bf_lo((unsigned)kvl[(size_t)t * 256 + 128 + j]), x2 = bf_lo((unsigned)kvl[(size_t)t * 256 + 144 + j]); const f32x2_t c = cs[i];
        kr[(size_t)t * 32 + j] = (bf16_t)(cvtpk(x1 * c.x - x2 * c.y, 0.f) & 0xffffu); kr[(size_t)t * 32 + 16 + j] = (bf16_t)(cvtpk(x2 * c.x + x1 * c.y, 0.f) & 0xffffu); }
}
__device__ __forceinline__ int crow(int r, int hi) { return (r & 3) + 8 * (r >> 2) + 4 * hi; }
__device__ __forceinline__ void att_glds16(const void* gsrc, unsigned lds_dst) { unsigned keep;
    asm volatile("s_mov_b32 %0, m0\n\ts_mov_b32 m0, %2\n\ts_nop 0\n\tglobal_load_lds_dwordx4 %1, off\n\ts_mov_b32 m0, %0" : "=&s"(keep) : "v"(gsrc), "s"(lds_dst) : "memory"); }
__device__ __forceinline__ float att_max3(float a, float b, float c) { return __builtin_fmaxf(__builtin_fmaxf(a, b), c); }
__device__ __forceinline__ float att_fadd(float a, float b) { float r; asm("v_add_f32_e32 %0, %1, %2" : "=v"(r) : "v"(a), "v"(b)); return r; }
__device__ __forceinline__ void att_wait(int n) {
    if (n >= 6) asm volatile("s_waitcnt vmcnt(6)" ::: "memory"); else if (n == 4) asm volatile("s_waitcnt vmcnt(4)" ::: "memory");
    else if (n == 3) asm volatile("s_waitcnt vmcnt(3)" ::: "memory"); else if (n == 2) asm volatile("s_waitcnt vmcnt(2)" ::: "memory"); else asm volatile("s_waitcnt vmcnt(0)" ::: "memory");
}
constexpr int ATT_SIDE_OFF = 86016;
static_assert(ATT_SIDE_OFF + 8 * 8704 <= LCTL_OFF, "attention side-job scratch");
template <bool MLA, int MODE = 0>
__device__ __forceinline__ void attn_unit(Frame& F, const bf16_t* Q1, int ldq1, const bf16_t* Q2, int ldq2, const bf16_t* K1, int ldk1, const bf16_t* K2, int ldk2,
                                          const bf16_t* V, int ldv, bf16_t* O, int ldo, int qb, const float* relh, KP P, int side_item) {
    constexpr int NS = MLA ? 6 : 4, K2OFF = 8192, VOFF = MLA ? 12288 : 8192, SLOT = VOFF + 8192, NSLOT = 4, BT_OFF = NSLOT * SLOT;
    LAS unsigned char* lds = F.lds + RING_OFF;
    LAS float* btab = (LAS float*)(lds + BT_OFF);
    const int tid = F.tid, lane = F.lane, wid = F.wave, r32 = lane & 31, hh = lane >> 5;
    const int q0 = qb * 256 + wid * 32, qc = q0 >> 6;
    const int kt_lo = MLA ? 0 : (4 * qb - 8 < 0 ? 0 : 4 * qb - 8), kt_hi = 4 * qb + 3;
    const int my_lo = MLA ? 0 : (qc - 8 < 0 ? 0 : qc - 8), my_hi = qc;
    const bf16_t* k1src = K1 + (size_t)(8 * wid + (lane >> 3)) * ldk1 + (((lane & 7) ^ ((4 * wid + (lane >> 4)) & 7)) << 3);
    const bf16_t* vsrc = V + (size_t)(16 * (wid & 3) + (lane >> 2)) * ldv + (wid >> 2) * 32 + ((lane & 3) << 3);
    const bf16_t* k2src = MLA ? K2 + (size_t)(16 * (wid & 3) + (lane >> 2)) * ldk2 + (((lane & 3) ^ ((lane >> 4) & 3)) << 3) : nullptr;
    const int npt = (MLA && wid < 4) ? 3 : 2;
    const unsigned lds_u = (unsigned)(unsigned long long)lds;
#define ATT_ISSUE(kt) do { const unsigned sl_ = (unsigned)__builtin_amdgcn_readfirstlane((int)(lds_u + ((kt) & 3) * SLOT + wid * 1024)); \
        att_glds16(k1src + (size_t)(kt) * 64 * ldk1, sl_); \
        att_glds16(vsrc + (size_t)(kt) * 64 * ldv, sl_ + VOFF); \
        if (MLA && wid < 4) att_glds16(k2src + (size_t)(kt) * 64 * ldk2, sl_ + K2OFF); } while (0)
    if (!MLA) { for (int i = tid; i < 640; i += NTHR) btab[i] = relh[i < 512 ? i : 512] * LOG2E; __syncthreads(); }
    ATT_ISSUE(kt_lo); if (kt_lo + 1 <= kt_hi) ATT_ISSUE(kt_lo + 1); if (kt_lo + 2 <= kt_hi) ATT_ISSUE(kt_lo + 2);
    bf16x8 qf[NS];
    { const bf16_t* qrow = Q1 + (size_t)(q0 + r32) * ldq1 + 8 * hh;
#pragma unroll
      for (int s = 0; s < 4; ++s) qf[s] = *(const bf16x8*)(qrow + 16 * s);
      if (MLA) { const bf16_t* qrow2 = Q2 + (size_t)(q0 + r32) * ldq2 + 8 * hh;
#pragma unroll
          for (int s = 4; s < NS; ++s) qf[s] = *(const bf16x8*)(qrow2 + 16 * (s - 4)); } }
    if (side_item >= 0 && side_item < N_DEFERRED) tr_deferred(P, side_item, (LAS float*)(F.lds + ATT_SIDE_OFF + wid * 8704), lane);
#pragma unroll
    for (int s = 0; s < NS; ++s) asm volatile("" : "+v"(qf[s]));
    float mref = 0.f, lrun = 0.f; bool first = true; f32x16 o0, o1, negm;
#pragma unroll
    for (int r = 0; r < 16; ++r) { o0[r] = 0.f; o1[r] = 0.f; negm[r] = 0.f; }
    int koff[NS];
#pragma unroll
    for (int s = 0; s < 4; ++s) koff[s] = r32 * 128 + (((2 * s + hh) ^ ((r32 >> 1) & 7)) << 4);
    if (MLA) {
#pragma unroll
        for (int s = 4; s < NS; ++s) koff[s] = K2OFF + r32 * 64 + (((2 * (s - 4) + hh) ^ ((r32 >> 2) & 3)) << 4); }
    const int vrd = VOFF + (4 * hh + ((lane & 15) >> 2)) * 64 + ((lane >> 4) & 1) * 32 + (lane & 3) * 8;
    { const int nout = (kt_hi - kt_lo < 2 ? kt_hi - kt_lo : 2); att_wait(nout * npt); }
    __builtin_amdgcn_s_barrier(); asm volatile("" ::: "memory");
    if (wid >= 4) __builtin_amdgcn_s_setprio(1);
    for (int kt = kt_lo; kt <= kt_hi; ++kt) {
        if (kt + 3 <= kt_hi) ATT_ISSUE(kt + 3);
        if (kt >= my_lo && kt <= my_hi) {
            const LAS unsigned char* Sb = lds + (kt & 3) * SLOT;
            f32x16 p0, p1;
            bf16x8 ka[NS], kb[NS];
#pragma unroll
            for (int s = 0; s < NS; ++s) { ka[s] = *(const LAS bf16x8*)(Sb + koff[s]); kb[s] = *(const LAS bf16x8*)(Sb + koff[s] + (s < 4 ? 4096 : 2048)); }
            __builtin_amdgcn_sched_barrier(0);
#pragma unroll
            for (int s = 0; s < NS; ++s) {
                if (MODE & 2) { asm volatile("" :: "v"(ka[s]), "v"(kb[s])); } else {
                if (s == 0) { p0 = __builtin_amdgcn_mfma_f32_32x32x16_bf16(ka[0], qf[0], negm, 0, 0, 0); p1 = __builtin_amdgcn_mfma_f32_32x32x16_bf16(kb[0], qf[0], negm, 0, 0, 0); }
                else { p0 = __builtin_amdgcn_mfma_f32_32x32x16_bf16(ka[s], qf[s], p0, 0, 0, 0); p1 = __builtin_amdgcn_mfma_f32_32x32x16_bf16(kb[s], qf[s], p1, 0, 0, 0); } }
            }
            bf16x8 vfr[4][2];
#pragma unroll
            for (int s = 0; s < 4; ++s)
#pragma unroll
                for (int ds = 0; ds < 2; ++ds) {
                    const LAS unsigned char* vb = Sb + vrd + ds * 4096 + s * 1024;
                    const v4i16_t lo = __builtin_amdgcn_ds_read_tr16_b64_v4i16((LAS v4i16_t*)vb);
                    const v4i16_t hi = __builtin_amdgcn_ds_read_tr16_b64_v4i16((LAS v4i16_t*)(vb + 512));
                    vfr[s][ds] = (bf16x8){lo[0], lo[1], lo[2], lo[3], hi[0], hi[1], hi[2], hi[3]}; }
            __builtin_amdgcn_sched_barrier(0);
            if (!MLA) {
                if (qc - kt >= 5) { const float bc = btab[512];
#pragma unroll
                    for (int r = 0; r < 16; ++r) { p0[r] += bc; p1[r] += bc; } }
                else {
                    const LAS float* bp = btab + ((q0 + r32) - kt * 64 + 256 - 4 * hh - 59); asm volatile("" : "+v"(bp));
#pragma unroll
                    for (int r = 0; r < 16; ++r) { p0[r] += bp[59 - ((r & 3) + 8 * (r >> 2))]; p1[r] += bp[27 - ((r & 3) + 8 * (r >> 2))]; } }
            }
            {
                float mx = att_max3(p0[0], p0[1], p1[0]), mb = att_max3(p0[2], p0[3], p1[1]); mx = att_max3(mx, p1[2], p1[3]);
#pragma unroll
                for (int r = 4; r < 16; r += 4) { mx = att_max3(mx, p0[r], p0[r + 1]); mb = att_max3(mb, p0[r + 2], p0[r + 3]); mx = att_max3(mx, p1[r], p1[r + 1]); mb = att_max3(mb, p1[r + 2], p1[r + 3]); }
                mx = __builtin_fmaxf(mx, mb);
                { auto rr = __builtin_amdgcn_permlane32_swap(__builtin_bit_cast(unsigned, mx), __builtin_bit_cast(unsigned, mx), false, false); mx = __builtin_fmaxf(__builtin_bit_cast(float, rr[0]), __builtin_bit_cast(float, rr[1])); }
                if (__builtin_expect(first || __any(mx > 8.0f), 0)) {
                    const float dl = first ? mx : __builtin_fmaxf(mx, 0.f); first = false; mref += dl;
                    const float f = __builtin_amdgcn_exp2f(-dl); lrun *= f;
#pragma unroll
                    for (int r = 0; r < 16; ++r) { p0[r] -= dl; p1[r] -= dl; o0[r] *= f; o1[r] *= f; negm[r] = -mref; }
                    asm volatile("" : "+v"(negm));
                }
                float sa = 0.f, sb = 0.f, sc2 = 0.f, sd = 0.f;
#pragma unroll
                for (int r = 0; r < 16; ++r) { p0[r] = __builtin_amdgcn_exp2f(p0[r]); p1[r] = __builtin_amdgcn_exp2f(p1[r]); }
#pragma unroll
                for (int r = 0; r < 16; r += 2) { sa = att_fadd(sa, p0[r]); sb = att_fadd(sb, p0[r + 1]); sc2 = att_fadd(sc2, p1[r]); sd = att_fadd(sd, p1[r + 1]); }
                lrun += att_fadd(att_fadd(sa, sb), att_fadd(sc2, sd));
            }
            u32x4 pw[4];
            pw[0] = (u32x4){cvtpk(p0[0], p0[1]), cvtpk(p0[2], p0[3]), cvtpk(p0[4], p0[5]), cvtpk(p0[6], p0[7])};
            pw[1] = (u32x4){cvtpk(p0[8], p0[9]), cvtpk(p0[10], p0[11]), cvtpk(p0[12], p0[13]), cvtpk(p0[14], p0[15])};
            pw[2] = (u32x4){cvtpk(p1[0], p1[1]), cvtpk(p1[2], p1[3]), cvtpk(p1[4], p1[5]), cvtpk(p1[6], p1[7])};
            pw[3] = (u32x4){cvtpk(p1[8], p1[9]), cvtpk(p1[10], p1[11]), cvtpk(p1[12], p1[13]), cvtpk(p1[14], p1[15])};
#pragma unroll
            for (int s = 0; s < 4; ++s) {
                const bf16x8 pf = __builtin_bit_cast(bf16x8, pw[s]);
                if (MODE & 2) { asm volatile("" :: "v"(vfr[s][0]), "v"(vfr[s][1]), "v"(pf)); }
                else { o0 = __builtin_amdgcn_mfma_f32_32x32x16_bf16(vfr[s][0], pf, o0, 0, 0, 0); o1 = __builtin_amdgcn_mfma_f32_32x32x16_bf16(vfr[s][1], pf, o1, 0, 0, 0); }
            }
        }
        if (kt < kt_hi) { const int nout = (kt_hi - kt - 1 < 2 ? kt_hi - kt - 1 : 2); att_wait(nout * npt); }
        asm volatile("s_waitcnt lgkmcnt(0)" ::: "memory");
        __builtin_amdgcn_s_barrier(); asm volatile("" ::: "memory");
    }
#undef ATT_ISSUE
    if (wid >= 4) __builtin_amdgcn_s_setprio(0);
    const float ltot = lrun + __shfl_xor(lrun, 32); const float il = 1.0f / ltot;
    bf16_t* orow = O + (size_t)(q0 + r32) * ldo;
#pragma unroll
    for (int g = 0; g < 4; ++g) {
        u32x2 w0, w1; w0.x = cvtpk(o0[4 * g] * il, o0[4 * g + 1] * il); w0.y = cvtpk(o0[4 * g + 2] * il, o0[4 * g + 3] * il);
        w1.x = cvtpk(o1[4 * g] * il, o1[4 * g + 1] * il); w1.y = cvtpk(o1[4 * g + 2] * il, o1[4 * g + 3] * il);
        *(u32x2*)(orow + 8 * g + 4 * hh) = w0; *(u32x2*)(orow + 32 + 8 * g + 4 * hh) = w1;
    }
}
template <int MODE = 0> __device__ __forceinline__ void p4_attention(KP P, Frame& F) {
    unsigned char* ws = P->ws;
    const bf16_t* QA = (const bf16_t*)(ws + WS_QA); const bf16_t* KN = (const bf16_t*)(ws + WS_KN); const bf16_t* VA = (const bf16_t*)(ws + WS_VA); const bf16_t* KR = (const bf16_t*)(ws + WS_KR);
    const bf16_t* QB = (const bf16_t*)(ws + WS_QB); const bf16_t* KB = (const bf16_t*)(ws + WS_KB); const bf16_t* VB = (const bf16_t*)(ws + WS_VB);
    bf16_t* OA = (bf16_t*)(ws + WS_OAB); bf16_t* OB = OA + (size_t)TT * 512;
#ifndef ATT_NOMLA
    int uc = 0;
#define ATT_SIDE() (uc < 8 ? F.vcu * 64 + uc * 8 + F.wave : -1)
    for (int p = F.vcu; p < NBF * 64; p += F.G) {
        const int bh = p >> 3, s = p & 7, b = bh >> 3, h = bh & 7; const size_t rb = (size_t)b * SEQ;
#pragma unroll 1
        for (int k = 0; k < 2; ++k) { const int qb = k ? s : 15 - s;
            attn_unit<true, MODE>(F, QA + rb * 768 + h * 64, 768, QA + rb * 768 + 512 + h * 32, 768, KN + rb * 512 + h * 64, 512, KR + rb * 32, 32, VA + rb * 512 + h * 64, 512, OA + rb * 512 + h * 64, 512, qb, nullptr, P, ATT_SIDE()); ++uc; }
    }
#endif
#ifndef ATT_NOBAND
    for (int u = F.vcu; u < NBF * 128; u += F.G) {
        const int bh = u >> 4, qb = u & 15, b = bh >> 3, h = bh & 7; const size_t rb = (size_t)b * SEQ;
        attn_unit<false, MODE>(F, QB + rb * 512 + h * 64, 512, nullptr, 0, KB + rb * 512 + h * 64, 512, nullptr, 0, VB + rb * 512 + h * 64, 512, OB + rb * 512 + h * 64, 512, qb, P->rel + h * 513, P, ATT_SIDE()); ++uc;
    }
#endif
    for (; uc < 8; ++uc) { const int it = ATT_SIDE(); if (it < N_DEFERRED) tr_deferred(P, it, (LAS float*)(F.lds + ATT_SIDE_OFF + F.wave * 8704), F.lane); }
#undef ATT_SIDE
}
}
namespace fx {
constexpr int P7_STRIDE = 1032;
constexpr int P7_PLANE = 36 * P7_STRIDE * 2;
static_assert(2 * P7_PLANE <= P7S_OFF, "router planes");
template <bool dry> __device__ __forceinline__ void p7_route(KP P, Frame& F) {
    const int tid = F.tid, lane = F.lane, wid = F.wave;
    LAS unsigned short* Whi = (LAS unsigned short*)(F.lds); LAS unsigned short* Wlo = (LAS unsigned short*)(F.lds + P7_PLANE);
    LAS int* lcnt = (LAS int*)(F.lds + P7S_OFF);
    LAS int* lbase = lcnt + 32;
    LAS float* cvec = (LAS float*)(lcnt + 64);
    LAS int* rec = lcnt + 128;
    LAS float* recw = (LAS float*)(F.lds + P7S_OFF + 4096);
    const int RPW = (TT + F.G - 1) / F.G;
    const float* mod = (const float*)(P->ws + CTL_MOD); const float* X1 = P->out;
    const int row_lo = F.vcu * RPW, b = row_lo / SEQ; const float* sh = mod + (size_t)b * 6144 + 3072; const float* sc = sh + 1024;
    if (tid < 32) lcnt[tid] = 0;
    float cp[36];
#pragma unroll
    for (int r = 0; r < 36; ++r) cp[r] = 0.f;
    f32x4 wv[2][9]; float gmk[2], shk[2];
#pragma unroll
    for (int kk = 0; kk < 2; ++kk) { const int k = tid + 512 * kk; gmk[kk] = P->g_ffn[k] * (1.f + sc[k]); shk[kk] = sh[k];
        const f32x4* wr = (const f32x4*)(P->w_re + (size_t)k * 32);
#pragma unroll
        for (int c4 = 0; c4 < 8; ++c4) wv[kk][c4] = wr[c4];
        wv[kk][8] = *(const f32x4*)(P->w_rg + (size_t)k * 4); }
#pragma unroll
    for (int kk = 0; kk < 2; ++kk) { const int k = tid + 512 * kk;
#pragma unroll
        for (int c4 = 0; c4 < 9; ++c4)
#pragma unroll
            for (int e4 = 0; e4 < 4; ++e4) {
                const int e = c4 * 4 + e4, g = e >> 3, i8 = e & 7, rho = (c4 < 8) ? (16 * (i8 >> 2) + 4 * g + (i8 & 3)) : (32 + e4);
                const float w = wv[kk][c4][e4]; cp[rho] += shk[kk] * w;
                const float v = w * gmk[kk]; const unsigned hi = cvtpk(v, 0.f) & 0xffffu; const unsigned lo = cvtpk(v - bf_lo(hi), 0.f) & 0xffffu;
                Whi[rho * P7_STRIDE + k] = (unsigned short)hi; Wlo[rho * P7_STRIDE + k] = (unsigned short)lo; }
    }
    {
        LAS float* cw = (LAS float*)(F.lds + P7S_OFF + 6144);
#pragma unroll
        for (int r = 0; r < 36; ++r) { const float sred = wave_sum(cp[r]); if (lane == 0) cw[wid * 36 + r] = sred; }
        __syncthreads();
        if (tid < 36) { float a = 0.f;
#pragma unroll
            for (int w = 0; w < 8; ++w) a += cw[w * 36 + tid];
            float bias; if (tid < 32) { const int jt = tid >> 4, g = (tid & 15) >> 2, i = tid & 3; bias = P->b_re[8 * g + 4 * jt + i]; } else bias = P->b_rg[tid - 32];
            cvec[tid] = a + bias; }
    }
    __syncthreads();
    const int row = lane & 15, q = lane >> 4;
    const float cg = cvec[32 + q]; float cv[2][4];
#pragma unroll
    for (int jt = 0; jt < 2; ++jt)
#pragma unroll
        for (int i = 0; i < 4; ++i) cv[jt][i] = cvec[16 * jt + 4 * q + i];
    float* rinv = (float*)(P->ws + WS_RT_RINV);
    const int arow2 = 32 + (row >> 2);
    const bool has = wid * 16 < RPW;
    const int m = row_lo + wid * 16 + row;
    const f32x4* xr = (const f32x4*)(X1 + (size_t)(has ? m : row_lo) * 1024 + 8 * q);
    if (has) {
        float inv;
        { const f32x4* sq = (const f32x4*)((const float*)(P->ws + WS_SSQ_X) + (size_t)m * 16); const f32x4 s0 = sq[0], s1 = sq[1], s2 = sq[2], s3 = sq[3];
          const float ssq = (((s0[0] + s0[1]) + (s0[2] + s0[3])) + ((s1[0] + s1[1]) + (s1[2] + s1[3]))) + (((s2[0] + s2[1]) + (s2[2] + s2[3])) + ((s3[0] + s3[1]) + (s3[2] + s3[3])));
          inv = 1.0f / sqrtf(ssq * (1.f / 1024.f) + EPS); }
        if (q == 0) rinv[m] = inv;
        f32x4 acc0 = {0.f, 0.f, 0.f, 0.f}, acc1 = acc0, acc2 = acc0;
        bf16_t* h2r = (bf16_t*)(P->ws + WS_H) + (size_t)m * 1024 + 8 * q; const float* gf = P->g_ffn + 8 * q; const float* scq = sc + 8 * q; const float* shq = sh + 8 * q;
        f32x4 xq[16];
#pragma unroll
        for (int j = 0; j < 16; ++j) xq[j] = xr[(j >> 1) * 8 + (j & 1)];
#pragma unroll 1
        for (int g = 0; g < 4; ++g) {
            f32x4 xn[16];
            if (g < 3) {
#pragma unroll
                for (int j = 0; j < 16; ++j) xn[j] = xr[(8 * (g + 1) + (j >> 1)) * 8 + (j & 1)]; }
            __builtin_amdgcn_sched_barrier(0);
#pragma unroll
            for (int kk = 0; kk < 8; ++kk) {
                const int ks = 8 * g + kk; const f32x4 xa = xq[2 * kk], xb = xq[2 * kk + 1];
                u32x4 xh, xl;
                xh.x = cvtpk(xa[0], xa[1]); xh.y = cvtpk(xa[2], xa[3]); xh.z = cvtpk(xb[0], xb[1]); xh.w = cvtpk(xb[2], xb[3]);
                xl.x = cvtpk(xa[0] - bf_lo(xh.x), xa[1] - bf_hi(xh.x)); xl.y = cvtpk(xa[2] - bf_lo(xh.y), xa[3] - bf_hi(xh.y));
                xl.z = cvtpk(xb[0] - bf_lo(xh.z), xb[1] - bf_hi(xh.z)); xl.w = cvtpk(xb[2] - bf_lo(xh.w), xb[3] - bf_hi(xh.w));
                const bf16x8 bh = __builtin_bit_cast(bf16x8, xh), bl = __builtin_bit_cast(bf16x8, xl);
                const int ko = ks * 32 + 8 * q;
                const bf16x8 a0h = *(const LAS bf16x8*)(Whi + row * P7_STRIDE + ko), a0l = *(const LAS bf16x8*)(Wlo + row * P7_STRIDE + ko);
                const bf16x8 a1h = *(const LAS bf16x8*)(Whi + (16 + row) * P7_STRIDE + ko), a1l = *(const LAS bf16x8*)(Wlo + (16 + row) * P7_STRIDE + ko);
                const bf16x8 a2h = *(const LAS bf16x8*)(Whi + arow2 * P7_STRIDE + ko), a2l = *(const LAS bf16x8*)(Wlo + arow2 * P7_STRIDE + ko);
                acc0 = __builtin_amdgcn_mfma_f32_16x16x32_bf16(a0h, bh, acc0, 0, 0, 0); acc0 = __builtin_amdgcn_mfma_f32_16x16x32_bf16(a0l, bh, acc0, 0, 0, 0); acc0 = __builtin_amdgcn_mfma_f32_16x16x32_bf16(a0h, bl, acc0, 0, 0, 0);
                acc1 = __builtin_amdgcn_mfma_f32_16x16x32_bf16(a1h, bh, acc1, 0, 0, 0); acc1 = __builtin_amdgcn_mfma_f32_16x16x32_bf16(a1l, bh, acc1, 0, 0, 0); acc1 = __builtin_amdgcn_mfma_f32_16x16x32_bf16(a1h, bl, acc1, 0, 0, 0);
                acc2 = __builtin_amdgcn_mfma_f32_16x16x32_bf16(a2h, bh, acc2, 0, 0, 0); acc2 = __builtin_amdgcn_mfma_f32_16x16x32_bf16(a2l, bh, acc2, 0, 0, 0); acc2 = __builtin_amdgcn_mfma_f32_16x16x32_bf16(a2h, bl, acc2, 0, 0, 0);
                const f32x4 ga = *(const f32x4*)(gf + ks * 32), gb = *(const f32x4*)(gf + ks * 32 + 4), sa = *(const f32x4*)(scq + ks * 32), sb = *(const f32x4*)(scq + ks * 32 + 4);
                const f32x4 ha = *(const f32x4*)(shq + ks * 32), hb = *(const f32x4*)(shq + ks * 32 + 4);
                f32x4 ya, yb;
#pragma unroll
                for (int e = 0; e < 4; ++e) { ya[e] = xa[e] * inv * (ga[e] * (1.f + sa[e])) + ha[e]; yb[e] = xb[e] * inv * (gb[e] * (1.f + sb[e])) + hb[e]; }
                *(u32x4*)(h2r + ks * 32) = pack8(ya, yb);
            }
            if (g < 3) {
#pragma unroll
                for (int j = 0; j < 16; ++j) xq[j] = xn[j]; }
        }
        const float lgq = inv * acc2[0] + cg;
        float gm1 = fmaxf(lgq, __shfl_xor(lgq, 16)); gm1 = fmaxf(gm1, __shfl_xor(gm1, 32));
        float es = __expf(lgq - gm1); es += __shfl_xor(es, 16); es += __shfl_xor(es, 32);
        int cand = (lgq == gm1) ? q : 4; { const int o1 = __shfl_xor(cand, 16); cand = cand < o1 ? cand : o1; const int o2 = __shfl_xor(cand, 32); cand = cand < o2 ? cand : o2; }
        const float gw = 1.f / es;
        float ev[8];
#pragma unroll
        for (int i = 0; i < 4; ++i) { ev[i] = inv * acc0[i] + cv[0][i]; ev[4 + i] = inv * acc1[i] + cv[1][i]; }
        float m1 = -1e30f; int i1 = 0;
#pragma unroll
        for (int j = 0; j < 8; ++j) if (ev[j] > m1) { m1 = ev[j]; i1 = j; }
        float m2 = -1e30f; int i2 = 0;
#pragma unroll
        for (int j = 0; j < 8; ++j) if (j != i1 && ev[j] > m2) { m2 = ev[j]; i2 = j; }
        const float p2 = __expf(m2 - m1), w1 = gw / (1.f + p2), w2 = gw * p2 / (1.f + p2);
        if (q == cand) {
            const int rl = wid * 16 + row, e1 = q * 8 + i1, e2 = q * 8 + i2;
            const int r1 = __hip_atomic_fetch_add(lcnt + e1, 1, __ATOMIC_RELAXED, __HIP_MEMORY_SCOPE_WORKGROUP), r2 = __hip_atomic_fetch_add(lcnt + e2, 1, __ATOMIC_RELAXED, __HIP_MEMORY_SCOPE_WORKGROUP);
            rec[rl * 4 + 0] = e1; rec[rl * 4 + 1] = e2; rec[rl * 4 + 2] = r1; rec[rl * 4 + 3] = r2; recw[rl * 2] = w1; recw[rl * 2 + 1] = w2;
        }
    }
    __syncthreads();
    unsigned* gcnt = (unsigned*)(P->ws + CTL_CNT);
    if (tid < 32) lbase[tid] = dry ? 0 : (int)__hip_atomic_fetch_add(gcnt + 64 * tid, (unsigned)lcnt[tid], __ATOMIC_RELAXED, __HIP_MEMORY_SCOPE_AGENT);
    __syncthreads();
    int* rt_e = (int*)(P->ws + WS_RT_E); int* rt_rank = (int*)(P->ws + WS_RT_RANK); float* rt_w = (float*)(P->ws + WS_RT_W);
    if (!dry && tid < RPW && row_lo + tid < TT) { const int mm = row_lo + tid; const int e1 = rec[tid * 4], e2 = rec[tid * 4 + 1];
        rt_e[mm * 2] = e1; rt_e[mm * 2 + 1] = e2; rt_rank[mm * 2] = lbase[e1] + rec[tid * 4 + 2]; rt_rank[mm * 2 + 1] = lbase[e2] + rec[tid * 4 + 3];
        rt_w[mm * 2] = recw[tid * 2]; rt_w[mm * 2 + 1] = recw[tid * 2 + 1];
        int* elist = (int*)(P->ws + WS_ELIST); float* ewt = (float*)(P->ws + WS_EWT);
        const int x1i = lbase[e1] + rec[tid * 4 + 2], x2i = lbase[e2] + rec[tid * 4 + 3];
        elist[(size_t)e1 * TT + x1i] = mm; ewt[(size_t)e1 * TT + x1i] = recw[tid * 2]; elist[(size_t)e2 * TT + x2i] = mm; ewt[(size_t)e2 * TT + x2i] = recw[tid * 2 + 1]; }
    __syncthreads();
}
__device__ __forceinline__ void moe_tables(KP P, Frame& F, LAS int* tab, LAS int* toff) {
    const unsigned* gcnt = (const unsigned*)(P->ws + CTL_CNT);
    LAS int* cnt_s = toff + 40;
    if (F.tid < 32) cnt_s[F.tid] = (int)__hip_atomic_load(gcnt + 64 * F.tid, __ATOMIC_RELAXED, __HIP_MEMORY_SCOPE_AGENT);
    __syncthreads();
    if (F.tid == 0) {
        int acc = 0;
        for (int e = 0; e < 32; ++e) { const int c = cnt_s[e]; const int nt = (c + 255) >> 8; toff[e] = acc;
            for (int j = 0; j < nt; ++j) tab[1 + acc + j] = e; acc += nt; }
        toff[32] = acc; tab[0] = acc;
    }
    __syncthreads();
}
__device__ __forceinline__ void p11_final(KP P, Frame& F, const LAS int* toff, const bool dry = false) {
    const int gw = F.vcu * NWAVES + F.wave, NGW = F.G * NWAVES, lane = F.lane;
    const float* mod = (const float*)(P->ws + CTL_MOD); const int* rt_e = (const int*)(P->ws + WS_RT_E); const int* rt_rank = (const int*)(P->ws + WS_RT_RANK); const bf16_t* YB = (const bf16_t*)(P->ws + WS_YB);
    for (int m0 = gw * 2; m0 < TT; m0 += NGW * 2) {
        f32x4 xv[2][4]; u32x2 ya[2][4], yc[2][4]; f32x4 gq[2][4];
#pragma unroll
        for (int rr = 0; rr < 2; ++rr) { const int m = m0 + rr; const float* gt = mod + (size_t)(m / SEQ) * 6144 + 5120;
            const int p1 = toff[rt_e[m * 2]] * 256 + rt_rank[m * 2], p2 = toff[rt_e[m * 2 + 1]] * 256 + rt_rank[m * 2 + 1];
            const u32x2* y1 = (const u32x2*)(YB + (size_t)p1 * 1024) + lane; const u32x2* y2 = (const u32x2*)(YB + (size_t)p2 * 1024) + lane;
            const f32x4* xr = (const f32x4*)(P->out + (size_t)m * 1024) + lane;
#pragma unroll
            for (int j = 0; j < 4; ++j) { xv[rr][j] = xr[64 * j]; ya[rr][j] = y1[64 * j]; yc[rr][j] = y2[64 * j]; gq[rr][j] = *(const f32x4*)(gt + 4 * lane + 256 * j); } }
#pragma unroll
        for (int rr = 0; rr < 2; ++rr) { const int m = m0 + rr;
            f32x4 v[4]; float s = 0.f;
#pragma unroll
            for (int j = 0; j < 4; ++j) { const f32x4 x4 = xv[rr][j]; const u32x2 a = ya[rr][j], c = yc[rr][j]; const f32x4 g = gq[rr][j];
                v[j][0] = x4[0] + g[0] * (bf_lo(a.x) + bf_lo(c.x)); v[j][1] = x4[1] + g[1] * (bf_hi(a.x) + bf_hi(c.x));
                v[j][2] = x4[2] + g[2] * (bf_lo(a.y) + bf_lo(c.y)); v[j][3] = x4[3] + g[3] * (bf_hi(a.y) + bf_hi(c.y));
                s += (v[j][0] * v[j][0] + v[j][1] * v[j][1]) + (v[j][2] * v[j][2] + v[j][3] * v[j][3]); }
            const float inv = 1.0f / sqrtf(wave_sum(s) * (1.f / 1024.f) + EPS);
            f32x4* xw = (f32x4*)(P->out + (size_t)m * 1024) + lane;
#pragma unroll
            for (int j = 0; j < 4; ++j) { const f32x4 g = *(const f32x4*)(P->g_final + 4 * lane + 256 * j); f32x4 o;
#pragma unroll
                for (int e = 0; e < 4; ++e) o[e] = v[j][e] * inv * g[e];
                if (dry) ((f32x4*)(P->ws + WS_H) + (size_t)m * 256 + lane)[64 * j] = o; else xw[64 * j] = o; }
        }
    }
}

constexpr int N_PHASES = 12;
#ifndef ALIGN56
#define ALIGN56 true
#endif
__global__ void __launch_bounds__(NTHR, 2) mega_fwd(Params P_by_value) {
    KP P = (KP)__builtin_amdgcn_kernarg_segment_ptr();
    extern __shared__ __attribute__((aligned(16))) unsigned char lds_raw[];
    Frame F;
    F.lds = (LAS unsigned char*)lds_raw;
    F.tid = threadIdx.x; F.lane = F.tid & 63; F.wave = __builtin_amdgcn_readfirstlane(F.tid >> 6);
    F.G = gridDim.x; { const int bx = blockIdx.x; F.vcu = (F.G % 8 == 0) ? (bx % 8) * (F.G / 8) + bx / 8 : bx; }
    unsigned char* ws = P->ws;
    F.ctl = (gu32*)(ws + WS_CTL);
    volatile LAS unsigned* MISC = (volatile LAS unsigned*)(F.lds + LCTL_OFF);
    LAS int* tab = (LAS int*)(F.lds + LCTL_OFF + 256);
    LAS int* toff = (LAS int*)(F.lds + LCTL_OFF + 256 + 2048);
    for (int u = F.tid; u < (LDS_BYTES - LCTL_OFF) / 4; u += NTHR) ((LAS unsigned*)(F.lds + LCTL_OFF))[u] = 0u;
    __syncthreads();
    XcdBarrier bar = xcd_barrier_post((unsigned*)(F.ctl + CW_BAR) + P->li * XCD_BAR_WORDS, MISC + 8);
    const int lo = P->ph_lo, hi = P->ph_hi;
#ifndef PH_MASK
#define PH_MASK 0xFFF
#endif
#define IN(k) ((((PH_MASK) >> (k)) & 1) && lo <= (k) && (k) < hi)
#define SEAM(k) do { if ((k) != 8 && IN(k) && IN((k) + 1)) xcd_barrier(bar); } while (0)
#define REFRESH() do { int t_ = threadIdx.x; asm volatile("" : "+v"(t_)); F.tid = t_; F.lane = t_ & 63; } while (0)
    LAS unsigned char* ring = F.lds + RING_OFF;
    bf16_t* H = (bf16_t*)(ws + WS_H);
    float* ssq_q = (float*)(ws + WS_SSQ_Q); float* ssq_kv = (float*)(ws + WS_SSQ_KV);
    bf16_t* GA = (bf16_t*)P->out; bf16_t* GB = GA + (size_t)TT * 1024;

#ifndef PH_REPEAT
#define PH_REPEAT 0
#endif
#define PHASE(k, ...) do { if (IN(k)) { REFRESH(); { __VA_ARGS__ } if (((PH_REPEAT) >> (k)) & 1) { xcd_barrier(bar); REFRESH(); { __VA_ARGS__ } } } SEAM(k); } while (0)
    PHASE(0, p0_prologue(P, F););
    PHASE(1, p1_norm(P, F););
    PHASE(2, {
        pg8::Gemm g{H, (const bf16_t*)(ws + WS_WIN), TT, NPROJ, 1024}; pg8::StaticOrder S; S.init(TT, NPROJ, F.G, (int)blockIdx.x);
        EpiProj E{(bf16_t*)(ws + WS_QLAT), (bf16_t*)(ws + WS_KVL), (bf16_t*)(ws + WS_QB), (bf16_t*)(ws + WS_KB), (bf16_t*)(ws + WS_VB), GA, GB, ssq_q, ssq_kv};
        pg8::gemm_phase<EpiProj, pg8::StaticOrder, true, true>(ring, g, S, E); });
    PHASE(3, {
        { pg8::Gemm g{(const bf16_t*)(ws + WS_QLAT), (const bf16_t*)(ws + WS_WUQ), TT, 768, 256}; pg8::StaticOrder S; S.init(TT, 768, F.G, (int)blockIdx.x);
          EpiQA E{(bf16_t*)(ws + WS_QA), ssq_q, (const float*)(ws + WS_CS)};
          pg8::gemm_phase<EpiQA, pg8::StaticOrder, true, true>(ring, g, S, E); }
        { pg8::Gemm g{(const bf16_t*)(ws + WS_KVL), (const bf16_t*)(ws + WS_WKV), TT, 1024, 256}; pg8::StaticOrder S; S.init(TT, 1024, F.G, (int)blockIdx.x);
          EpiKV E{(bf16_t*)(ws + WS_KN), (bf16_t*)(ws + WS_VA), ssq_kv};
          pg8::gemm_phase<EpiKV, pg8::StaticOrder, true, true>(ring, g, S, E); }
        REFRESH();
        p3_krope(P, F); });
#ifdef ATT_PROBE
    if (IN(4)) { REFRESH(); p4_attention<ATT_PROBE>(P, F); xcd_barrier(bar); }
#endif
    PHASE(4, p4_attention<0>(P, F););
    PHASE(5, {
        pg8::Gemm g{(const bf16_t*)(ws + WS_OAB), (const bf16_t*)(ws + WS_WOAB), 2 * TT, 2048, 512}; PairOrder S; S.init(F.G, (int)blockIdx.x);
        EpiMerge E{(bf16_t*)(ws + WS_MERGED), GA, GB};
        pg8::gemm_phase<EpiMerge, PairOrder, ALIGN56, true>(ring, g, S, E); });
    PHASE(6, {
        pg8::Gemm g{(const bf16_t*)(ws + WS_MERGED), (const bf16_t*)(ws + WS_WOUT), TT, 1024, 1024}; pg8::StaticOrder S; S.init(TT, 1024, F.G, (int)blockIdx.x);
        EpiResid E{P->x, P->out, (const float*)(ws + CTL_MOD), (float*)(ws + WS_SSQ_X)};
        pg8::gemm_phase<EpiResid, pg8::StaticOrder, ALIGN56, true>(ring, g, S, E); });
    if (IN(7) && ((PH_REPEAT >> 7) & 1)) { REFRESH(); p7_route<true>(P, F); xcd_barrier(bar); }
    if (IN(7)) { REFRESH(); p7_route<false>(P, F); } SEAM(7);
    PHASE(9, {
        moe_tables(P, F, tab, toff);
        pg8::Gemm g{(const bf16_t*)(ws + WS_H), (const bf16_t*)(ws + WS_WGU), MOE_ROWS, 32 * 512, 1024}; MoeOrderT<true> S{(const int*)(ws + WS_ELIST), toff, tab, 2, F.G, F.vcu};
        EpiGU E{(bf16_t*)(ws + WS_HID), (const float*)(ws + WS_EWT), tab, toff};
        pg8::gemm_phase<EpiGU, MoeOrderT<true>, true, true>(ring, g, S, E); });
    PHASE(10, {
        if (!IN(9)) moe_tables(P, F, tab, toff);
        pg8::Gemm g{(const bf16_t*)(ws + WS_HID), (const bf16_t*)(ws + WS_WD), MOE_ROWS, 32 * 1024, 256}; MoeOrder S{nullptr, toff, tab, 4, F.G, F.vcu};
        EpiDown E{(bf16_t*)(ws + WS_YB)};
        pg8::gemm_phase<EpiDown, MoeOrder, true, true>(ring, g, S, E); });
    if (IN(11) && ((PH_REPEAT >> 11) & 1)) { REFRESH(); p11_final(P, F, toff, true); xcd_barrier(bar); }
    if (IN(11)) { REFRESH(); if (!IN(10)) moe_tables(P, F, tab, toff); p11_final(P, F, toff); }
#undef IN
#undef SEAM
}

static void fill_params(Params& p, void* const* d_in, float* out, void* ws) {
    p.x = (const float*)d_in[0]; p.c = (const float*)d_in[1]; p.pos = (const int*)d_in[2]; p.w_ada = (const float*)d_in[3]; p.b_ada = (const float*)d_in[4];
    p.g_mix = (const float*)d_in[5]; p.w_in = (const float*)d_in[6]; p.g_q = (const float*)d_in[7]; p.w_uq = (const float*)d_in[8]; p.g_kv = (const float*)d_in[9];
    p.w_uk = (const float*)d_in[10]; p.w_uv = (const float*)d_in[11]; p.rel = (const float*)d_in[12]; p.w_oa = (const float*)d_in[13]; p.w_ob = (const float*)d_in[14];
    p.w_out = (const float*)d_in[15]; p.g_ffn = (const float*)d_in[16]; p.w_rg = (const float*)d_in[17]; p.b_rg = (const float*)d_in[18]; p.w_re = (const float*)d_in[19];
    p.b_re = (const float*)d_in[20]; p.w_gate = (const float*)d_in[21]; p.w_up = (const float*)d_in[22]; p.w_down = (const float*)d_in[23]; p.g_final = (const float*)d_in[24];
    p.out = out; p.ws = (unsigned char*)ws;
}
static bool launch(void* const* d_in, float* out, void* ws, hipStream_t stream, int mode, int ph_lo = 0, int ph_hi = N_PHASES, int li = 0, bool do_memset = true) {
    static int grid = 0;
    if (grid == 0) {
        int dev = 0, cus = 0;
        if (hipGetDevice(&dev) != hipSuccess || hipDeviceGetAttribute(&cus, hipDeviceAttributeMultiprocessorCount, dev) != hipSuccess) { fprintf(stderr, "kernel_launch: device query failed\n"); grid = -1; return false; }
        if (hipFuncSetAttribute((const void*)mega_fwd, hipFuncAttributeMaxDynamicSharedMemorySize, LDS_BYTES) != hipSuccess) { fprintf(stderr, "kernel_launch: hipFuncSetAttribute failed\n"); grid = -1; return false; }
        int per_cu = 0;
        if (hipOccupancyMaxActiveBlocksPerMultiprocessor(&per_cu, (const void*)mega_fwd, NTHR, LDS_BYTES) != hipSuccess || per_cu < 1) fprintf(stderr, "kernel_launch: note: occupancy query says %d workgroups per CU\n", per_cu);
        (void)hipGetLastError();
        grid = cus;
        if (grid != 256) fprintf(stderr, "kernel_launch: note: %d CUs (built for 256)\n", grid);
    }
    if (grid < 0) return false;
    if (do_memset) (void)hipMemsetAsync((char*)ws + WS_CTL, 0, CTL_ZERO_BYTES, stream);
    Params p{}; fill_params(p, d_in, out, ws); p.li = li;
    if (mode == 0) { p.ph_lo = ph_lo; p.ph_hi = ph_hi; hipLaunchKernelGGL(mega_fwd, dim3(grid), dim3(NTHR), LDS_BYTES, stream, p); }
    else for (int k = ph_lo; k < ph_hi; ++k) { p.ph_lo = k; p.ph_hi = k + 1; hipLaunchKernelGGL(mega_fwd, dim3(grid), dim3(NTHR), LDS_BYTES, stream, p); }
    return true;
}
}
#ifndef DBG
#define DBG 0
#endif
#ifndef LAUNCH_MODE
#define LAUNCH_MODE 0
#endif
extern "C" void kernel_launch(void* const* d_in, const int* in_sizes, int n_in, void* d_out, int out_size, void* d_ws, size_t ws_size, hipStream_t stream) {
#if !DBG
    fx::launch(d_in, (float*)d_out, d_ws, stream, LAUNCH_MODE);
#else
    using namespace fx;
    constexpr size_t WS_OUTF = 152 * MiB, WS_ACC = 168 * MiB, WS_NAIVE = 176 * MiB;
    static_assert(WS_FAST_END <= WS_OUTF, "debug map");
    unsigned char* ws = (unsigned char*)d_ws; float* outf = (float*)(ws + WS_OUTF); float* acc = (float*)(ws + WS_ACC);
    nv::In in; nv::fill_in(in, d_in);
    nv::Scratch sc; sc.carve((float*)(ws + WS_NAIVE));
    (void)hipMemsetAsync(acc, 0, 4096, stream);
    hipLaunchKernelGGL(nv::k_mod, dim3(6144 / 256, 8), dim3(256), 0, stream, in.c, in.w_ada, in.b_ada, sc.mod);
    for (int b = nv::NB - 1; b >= 0; --b) nv::forward_batch(in, sc, b, (float*)d_out, stream);
    const int R = TT;
#define CMPB(s, F, ldf, fs, Rp, ldr, rows, cols, rsig) hipLaunchKernelGGL(dbg::k_cmp<true>, dim3(256), dim3(256), 0, stream, (const void*)(F), ldf, fs, Rp, ldr, rows, cols, rsig, acc, s)
#define CMPF(s, F, ldf, fs, Rp, ldr, rows, cols, rsig) hipLaunchKernelGGL(dbg::k_cmp<false>, dim3(256), dim3(256), 0, stream, (const void*)(F), ldf, fs, Rp, ldr, rows, cols, rsig, acc, s)
    launch(d_in, outf, d_ws, stream, LAUNCH_MODE, 0, 6, 0, true);
    CMPF(1, ws + CTL_MOD, 6144, 1.f, sc.mod, 6144, NBF, 6144, 0);
    CMPB(2, ws + WS_H, 1024, 1.f, sc.h, 1024, R, 1024, 0);
    CMPB(3, ws + WS_QLAT, 256, 1.f, sc.proj + nv::C_QLAT, nv::INW, R, 256, 0);
    CMPB(4, ws + WS_KVL, 256, 1.f, sc.proj + nv::C_KVLAT, nv::INW, R, 160, 0);
    CMPB(5, ws + WS_QB, 512, 1.f / C2B, sc.proj + nv::C_QB, nv::INW, R, 512, 0);
    CMPB(6, ws + WS_KB, 512, 1.f, sc.proj + nv::C_KB, nv::INW, R, 512, 0);
    CMPB(7, ws + WS_VB, 512, 1.f, sc.proj + nv::C_VB, nv::INW, R, 512, 0);
    CMPB(8, (unsigned short*)outf, 1024, 1.f, sc.proj + nv::C_GA, nv::INW, R, 1024, 1);
    CMPB(9, (unsigned short*)outf + (size_t)TT * 1024, 1024, 1.f, sc.proj + nv::C_GB, nv::INW, R, 1024, 1);
    for (int h = 0; h < 8; ++h) { CMPB(10, (unsigned short*)(ws + WS_QA) + h * 64, 768, 1.f / C2A, sc.qa + h * 96, 768, R, 64, 0); CMPB(11, (unsigned short*)(ws + WS_QA) + 512 + h * 32, 768, 1.f / C2A, sc.qa + h * 96 + 64, 768, R, 32, 0); }
    CMPB(12, ws + WS_KN, 512, 1.f, sc.kn, 512, R, 512, 0);
    CMPB(13, ws + WS_VA, 512, 1.f, sc.va, 512, R, 512, 0);
    CMPB(14, ws + WS_KR, 32, 1.f, sc.kr, 32, R, 32, 0);
    CMPB(15, ws + WS_OAB, 512, 1.f, sc.oa, 512, R, 512, 0);
    CMPB(16, (unsigned short*)(ws + WS_OAB) + (size_t)TT * 512, 512, 1.f, sc.ob, 512, R, 512, 0);
    CMPB(17, ws + WS_MERGED, 1024, 1.f, sc.A, 1024, R, 1024, 0);
    launch(d_in, outf, d_ws, stream, LAUNCH_MODE, 6, 7, 1, false);
    CMPF(18, outf, 1024, 1.f, sc.x1, 1024, R, 1024, 0);
    launch(d_in, outf, d_ws, stream, LAUNCH_MODE, 7, N_PHASES, 2, false);
    hipLaunchKernelGGL(dbg::k_cmp_route, dim3((R + 255) / 256), dim3(256), 0, stream, (const int*)(ws + WS_RT_E), (const float*)(ws + WS_RT_W), sc.rt_e, sc.rt_w, R, acc, 20);
    CMPF(21, outf, 1024, 1.f, (const float*)d_out, 1024, R, 1024, 0);
    hipLaunchKernelGGL(dbg::k_scale, dim3(1024), dim3(256), 0, stream, (float*)d_out, (size_t)nv::NB * nv::S * 1024, acc, 22, 0.03f, DBG_FIRST);
#endif
}
```

```cpp
#include <hip/hip_runtime.h>
#include <hip/hip_bf16.h>
#include <cstdio>
#include <cstdint>
#include <cmath>
namespace pg8 {
#define PG8_LAS __attribute__((address_space(3)))
typedef unsigned short bf16_t;
typedef short bf16x8 __attribute__((ext_vector_type(8)));
typedef float f32x4 __attribute__((ext_vector_type(4)));
typedef unsigned u32x4 __attribute__((ext_vector_type(4)));
constexpr int BM = 256, BK = 64, HALF = 128, HTB = HALF * BK * 2  , STAGE_BYTES = 8 * HTB, NXCD = 8, WGM = 8;

__host__ __device__ __forceinline__ int lds_byte(int r, int c) { const int st = (r >> 4) * 2 + (c >> 5), rr = r & 15, cc = c & 31, ob = rr * 64 + cc * 2; return st * 1024 + (ob ^ (((ob >> 9) & 1) << 5)); }
__host__ __device__ __forceinline__ void stage_rc(int b, int& R, int& C) { const int st = b / 1024, sb = b % 1024, swz = sb ^ (((sb >> 9) & 1) << 5); R = (st >> 1) * 16 + swz / 64; C = (st & 1) * 32 + (swz % 64) / 2; }
__host__ __device__ __forceinline__ int perm32(int rho) { const int n = rho >> 4, i = rho & 15; return 8 * (i >> 2) + 4 * n + (i & 3); }

struct Unit { int pm, pn; };
struct Gemm { const bf16_t* A; const bf16_t* Bt; int M, N, K; };

struct StaticOrder {
    static constexpr bool GATHER = false; __device__ __forceinline__ unsigned a_row_off(int) const { return 0u; }
    int nM, nN, nwg, G, c;
    __host__ __device__ void init(int M, int N, int G_, int c_) { nM = M / BM; nN = N / BM; nwg = nM * nN; G = G_; c = c_; }
    __host__ __device__ bool next(int i, Unit& u) const {
        const long L = (long)i * G + c; if (L >= nwg) return false;
        int wgid = (int)L; { const int q = nwg / NXCD, r = nwg % NXCD, xcd = wgid % NXCD, off = wgid / NXCD; wgid = (xcd < r ? xcd * (q + 1) : r * (q + 1) + (xcd - r) * q) + off; }
        const int nig = WGM * nN, gid = wgid / nig, fm = gid * WGM, gsz = (nM - fm) < WGM ? (nM - fm) : WGM;
        u.pm = fm + ((wgid % nig) % gsz); u.pn = (wgid % nig) / gsz; return true;
    }
    __device__ __forceinline__ void a_ready(const Unit&) const {}
    __device__ __forceinline__ void done(const Unit&) const {}
};
__device__ __forceinline__ unsigned cvt_pk_bf16(float lo, float hi) { unsigned r; asm volatile("v_cvt_pk_bf16_f32 %0, %1, %2" : "=v"(r) : "v"(lo), "v"(hi)); return r; }
typedef float f32x2 __attribute__((ext_vector_type(2)));
template <class Epi, class Sched, bool ALIGN_EPI = false, bool SP2 = false>
__device__ __forceinline__ void gemm_phase(PG8_LAS unsigned char* lds, const Gemm g, const Sched& S, const Epi& E) {
    const int tid = threadIdx.x, wid = __builtin_amdgcn_readfirstlane(tid >> 6), lane = tid & 63, wr = wid >> 2, wc = wid & 3, fr = lane & 15, fq = lane >> 4;
    const int K = g.K, nt = K / BK;
    unsigned voffA[2], voffB[2];
    constexpr bool GA = Sched::GATHER;
    unsigned gC[2][2] = {{0u, 0u}, {0u, 0u}}, gN[2][2] = {{0u, 0u}, {0u, 0u}}; int gR[2] = {0, 0}; unsigned gCc[2] = {0u, 0u};
#pragma unroll
    for (int i = 0; i < 2; ++i) { int R, C; stage_rc(tid * 16 + i * 8192, R, C); const int Rb = Epi::PERM ? ((R & ~31) + perm32(R & 31)) : R;
        voffA[i] = (unsigned)(R * K + C) * 2u; voffB[i] = (unsigned)(Rb * K + C) * 2u; gR[i] = R; gCc[i] = (unsigned)C * 2u; }
#define PG8_GOFF(dst, u) do { _Pragma("unroll") for (int h_ = 0; h_ < 2; ++h_) _Pragma("unroll") for (int i_ = 0; i_ < 2; ++i_) dst[h_][i_] = S.a_row_off((u).pm * BM + h_ * HALF + gR[i_]) + gCc[i_]; } while (0)
#define PG8_STAGE_A(bufoff, h, base, nx) do { if constexpr (GA) { unsigned vv_[2] = {(nx) ? gN[h][0] : gC[h][0], (nx) ? gN[h][1] : gC[h][1]}; PG8_STAGE(bufoff, base, vv_); } else { PG8_STAGE(bufoff, (base) + (h) * hstep, voffA); } } while (0)
    const size_t kstep = (size_t)(BK * 2);
    const size_t hstep = (size_t)HALF * K * 2;
    const size_t tstep = 2 * hstep;
    const unsigned ldsw = (unsigned)wid * 1024u;
    const int aoff = lds_byte(wr * 64 + fr, fq * 8), boff = lds_byte(wc * 32 + fr, fq * 8);
#define PG8_SA(b, h) (((b) * 2 + (h)) * HTB)
#define PG8_SB(b, h) ((4 + (b) * 2 + (h)) * HTB)
#define PG8_STAGE(bufoff, gbase, voff) do { _Pragma("unroll") for (int _i = 0; _i < 2; ++_i) \
        __builtin_amdgcn_global_load_lds((const unsigned*)((const char*)(gbase) + (voff)[_i]), (PG8_LAS unsigned*)(lds + (bufoff) + ldsw + _i * 8192), 16, 0, 0); } while (0)
#define PG8_LDA(dst, b, h) do { _Pragma("unroll") for (int m = 0; m < 4; ++m) _Pragma("unroll") for (int k = 0; k < 2; ++k) dst[m][k] = *(const PG8_LAS bf16x8*)(lds + PG8_SA(b, h) + aoff + m * 2048 + k * 1024); } while (0)
#define PG8_LDB(dst, b, h) do { _Pragma("unroll") for (int n = 0; n < 2; ++n) _Pragma("unroll") for (int k = 0; k < 2; ++k) dst[n][k] = *(const PG8_LAS bf16x8*)(lds + PG8_SB(b, h) + boff + n * 2048 + k * 1024); } while (0)
#define PG8_MMA(ai, bj, At, Bt) do { __builtin_amdgcn_s_setprio(1); _Pragma("unroll") for (int m = 0; m < 4; ++m) _Pragma("unroll") for (int n = 0; n < 2; ++n) _Pragma("unroll") for (int k = 0; k < 2; ++k) \
        acc[ai][bj][m][n] = __builtin_amdgcn_mfma_f32_16x16x32_bf16(Bt[n][k], At[m][k], acc[ai][bj][m][n], 0, 0, 0); __builtin_amdgcn_s_setprio(0); } while (0)
#define PG8_WAIT_V(n) asm volatile("s_waitcnt vmcnt(" #n ")" ::: "memory")
#define PG8_WAIT_L(n) asm volatile("s_waitcnt lgkmcnt(" #n ")" ::: "memory")
#define PG8_BAR __builtin_amdgcn_s_barrier()
#define PG8_SCHED __builtin_amdgcn_sched_barrier(0)
    Unit cur, nxt; int ui = 0;
    if (!S.next(0, cur)) return;
    f32x4 acc[2][2][4][2];
#pragma unroll
    for (int a = 0; a < 2; ++a)
#pragma unroll
        for (int b = 0; b < 2; ++b)
#pragma unroll
            for (int m = 0; m < 4; ++m)
#pragma unroll
                for (int n = 0; n < 2; ++n) acc[a][b][m][n] = (f32x4){0.f, 0.f, 0.f, 0.f};
    bf16x8 At[4][2], B0[2][2], B1[2][2];
    const char* cA = (const char*)g.A + (GA ? (size_t)0 : (size_t)cur.pm * tstep); const char* cB = (const char*)g.Bt + (size_t)cur.pn * tstep;
    if constexpr (GA) PG8_GOFF(gC, cur);
    S.a_ready(cur);
    static_assert(SP2 || !GA, "gathered A rows: SP2 loop only");
    if constexpr (SP2) {
        PG8_STAGE(PG8_SB(0, 0), cB, voffB); PG8_STAGE(PG8_SB(0, 1), cB + hstep, voffB); PG8_STAGE_A(PG8_SA(0, 0), 0, cA, false); PG8_STAGE_A(PG8_SA(0, 1), 1, cA, false);
        if (wr == 1) PG8_BAR;
        PG8_WAIT_V(2); PG8_BAR;
        PG8_STAGE(PG8_SB(1, 0), cB + kstep, voffB); PG8_STAGE_A(PG8_SA(1, 0), 0, cA + kstep, false); PG8_STAGE(PG8_SB(1, 1), cB + hstep + kstep, voffB);
        PG8_WAIT_V(6); PG8_BAR;
    } else {
        PG8_STAGE(PG8_SB(0, 0), cB, voffB); PG8_STAGE(PG8_SA(0, 0), cA, voffA); PG8_STAGE(PG8_SB(0, 1), cB + hstep, voffB); PG8_STAGE(PG8_SA(0, 1), cA + hstep, voffA);
        if (wr == 1) PG8_BAR;
        PG8_WAIT_V(4); PG8_BAR;
        PG8_STAGE(PG8_SB(1, 0), cB + kstep, voffB); PG8_STAGE(PG8_SA(1, 0), cA + kstep, voffA); PG8_STAGE(PG8_SB(1, 1), cB + hstep + kstep, voffB);
        PG8_WAIT_V(6); PG8_BAR;
    }
    for (;;) {
        const bool has_next = S.next(ui + 1, nxt);
        const char* nA = (has_next && !GA) ? (const char*)g.A + (size_t)nxt.pm * tstep : cA; if constexpr (GA) { if (has_next) PG8_GOFF(gN, nxt); }
        const char* nB = has_next ? (const char*)g.Bt + (size_t)nxt.pn * tstep : cB;
        _Pragma("unroll 1") for (int t = 0; t < nt; t += 2) {
            const bool last = (t == nt - 2);
            const char* a1 = cA + (size_t)(t + 1) * kstep;
            const char* a2 = last ? nA : cA + (size_t)(t + 2) * kstep; const char* b2 = last ? nB : cB + (size_t)(t + 2) * kstep;
            const char* a3 = a2 + kstep; const char* b3 = b2 + kstep;
            if (last && has_next) S.a_ready(nxt);
            if constexpr (SP2) {
            PG8_LDB(B0, 0, 0); PG8_LDB(B1, 0, 1); PG8_SCHED; PG8_LDA(At, 0, 0); PG8_STAGE_A(PG8_SA(1, 1), 1, a1, false);
            PG8_WAIT_V(8); PG8_WAIT_L(0); PG8_BAR; PG8_MMA(0, 0, At, B0); PG8_MMA(0, 1, At, B1); PG8_BAR; PG8_SCHED;
            PG8_LDA(At, 0, 1); PG8_STAGE(PG8_SB(0, 0), b2, voffB); PG8_STAGE(PG8_SB(0, 1), b2 + hstep, voffB); PG8_STAGE_A(PG8_SA(0, 0), 0, a2, last && has_next);
            PG8_WAIT_V(8); PG8_WAIT_L(0); PG8_BAR; PG8_MMA(1, 0, At, B0); PG8_MMA(1, 1, At, B1); PG8_BAR; PG8_SCHED;
            PG8_LDB(B0, 1, 0); PG8_LDB(B1, 1, 1); PG8_SCHED; PG8_LDA(At, 1, 0); PG8_STAGE_A(PG8_SA(0, 1), 1, a2, last && has_next);
            PG8_WAIT_V(8); PG8_WAIT_L(0); PG8_BAR; PG8_MMA(0, 0, At, B0); PG8_MMA(0, 1, At, B1); PG8_BAR; PG8_SCHED;
            PG8_LDA(At, 1, 1); PG8_STAGE(PG8_SB(1, 0), b3, voffB); PG8_STAGE(PG8_SB(1, 1), b3 + hstep, voffB); PG8_STAGE_A(PG8_SA(1, 0), 0, a3, last && has_next);
            PG8_WAIT_V(8); PG8_WAIT_L(0); PG8_BAR; PG8_MMA(1, 0, At, B0); PG8_MMA(1, 1, At, B1); PG8_BAR; PG8_SCHED;
            } else {
            PG8_LDB(B0, 0, 0); PG8_SCHED; PG8_LDA(At, 0, 0); PG8_STAGE(PG8_SA(1, 1), a1 + hstep, voffA);
            PG8_WAIT_L(8); PG8_BAR; PG8_WAIT_L(0); PG8_MMA(0, 0, At, B0); PG8_BAR; PG8_SCHED;
            PG8_LDB(B1, 0, 1); PG8_STAGE(PG8_SB(0, 0), b2, voffB);
            PG8_BAR; PG8_WAIT_L(0); PG8_MMA(0, 1, At, B1); PG8_BAR;
            PG8_LDA(At, 0, 1); PG8_STAGE(PG8_SA(0, 0), a2, voffA);
            PG8_BAR; PG8_WAIT_L(0); PG8_MMA(1, 0, At, B0); PG8_BAR; PG8_SCHED;
            PG8_STAGE(PG8_SB(0, 1), b2 + hstep, voffB);
            PG8_WAIT_V(6); PG8_BAR; PG8_MMA(1, 1, At, B1); PG8_BAR;
            PG8_LDB(B0, 1, 0); PG8_SCHED; PG8_LDA(At, 1, 0); PG8_STAGE(PG8_SA(0, 1), a2 + hstep, voffA);
            PG8_WAIT_L(8); PG8_BAR; PG8_WAIT_L(0); PG8_MMA(0, 0, At, B0); PG8_BAR; PG8_SCHED;
            PG8_LDB(B1, 1, 1); PG8_STAGE(PG8_SB(1, 0), b3, voffB);
            PG8_BAR; PG8_WAIT_L(0); PG8_MMA(0, 1, At, B1); PG8_BAR;
            PG8_LDA(At, 1, 1); PG8_STAGE(PG8_SA(1, 0), a3, voffA);
            PG8_BAR; PG8_WAIT_L(0); PG8_MMA(1, 0, At, B0); PG8_BAR; PG8_SCHED;
            PG8_STAGE(PG8_SB(1, 1), b3 + hstep, voffB);
            PG8_WAIT_V(6); PG8_BAR; PG8_MMA(1, 1, At, B1); PG8_BAR;
            }
        }
        if constexpr (ALIGN_EPI) { if (wr == 0) PG8_BAR; }
        bool kept = false;
        if constexpr (!Epi::AFTER_DRAIN) {
            if constexpr (Epi::MID) { if (E.is_mid(cur)) { E.mid(acc, cur, wr, wc, fr, fq); kept = true; } else E(acc, cur, wr, wc, fr, fq); }
            else E(acc, cur, wr, wc, fr, fq);
            S.done(cur); }
        if (!has_next) break;
        if (!kept)
#pragma unroll
        for (int a = 0; a < 2; ++a)
#pragma unroll
            for (int b = 0; b < 2; ++b)
#pragma unroll
                for (int m = 0; m < 4; ++m)
#pragma unroll
                    for (int n = 0; n < 2; ++n) acc[a][b][m][n] = (f32x4){0.f, 0.f, 0.f, 0.f};
        cur = nxt; cA = nA; cB = nB; ++ui;
        if constexpr (GA) { _Pragma("unroll") for (int h_ = 0; h_ < 2; ++h_) _Pragma("unroll") for (int i_ = 0; i_ < 2; ++i_) gC[h_][i_] = gN[h_][i_]; }
        if constexpr (ALIGN_EPI) { if (wr == 1) PG8_BAR; }
    }
    PG8_WAIT_V(0);
    if constexpr (!ALIGN_EPI) { if (wr == 0) PG8_BAR; }
    PG8_BAR;
    if constexpr (Epi::AFTER_DRAIN) { E.fused(acc, cur, wr, wc, fr, fq, lds, wid, lane); S.done(cur); }
#undef PG8_SA
#undef PG8_GOFF
#undef PG8_STAGE_A
#undef PG8_SB
#undef PG8_STAGE
#undef PG8_LDA
#undef PG8_LDB
#undef PG8_MMA
#undef PG8_WAIT_V
#undef PG8_WAIT_L
#undef PG8_BAR
#undef PG8_SCHED
}
}
#define GAS __attribute__((address_space(1)))
#define LAS __attribute__((address_space(3)))
typedef unsigned short bf16;
typedef unsigned v4u __attribute__((ext_vector_type(4)));
typedef float f32x4 __attribute__((ext_vector_type(4)));
typedef short bf16x8 __attribute__((ext_vector_type(8)));
typedef GAS unsigned gu32;
typedef GAS unsigned long long gu64;
#define RLX_AGENT __ATOMIC_RELAXED, __HIP_MEMORY_SCOPE_AGENT
#define LDS_WAIT() asm volatile("s_waitcnt lgkmcnt(0)" ::: "memory")
#define VM_WAIT() asm volatile("s_waitcnt vmcnt(0)" ::: "memory")
__device__ __forceinline__ unsigned long long rt() { return __builtin_amdgcn_s_memrealtime(); }
__device__ __forceinline__ unsigned f2bf(float f) { unsigned u = __builtin_bit_cast(unsigned, f); return (u + 0x7fffu + ((u >> 16) & 1u)) >> 16; }
__device__ __forceinline__ unsigned pk2(float lo, float hi) { return f2bf(lo) | (f2bf(hi) << 16); }
#define XB_TMO      128
#define XB_XCNT(j)  (256  + 64 * (j))
#define XB_XSUB(j)  (1280 + 64 * (j))
#define XB_XGEN(j)  (2304 + 64 * (j))
#define XB_TOP      3328
#define XB_TOPGEN   3392
#define XCD_BAR_WORDS 3456
#define XB_SPIN_CAP (1u << 18)

__device__ __forceinline__ unsigned xb_ld(unsigned* p)              { return __hip_atomic_load(p, __ATOMIC_RELAXED, __HIP_MEMORY_SCOPE_AGENT); }
__device__ __forceinline__ unsigned xb_add(unsigned* p, unsigned v) { return __hip_atomic_fetch_add(p, v, __ATOMIC_RELAXED, __HIP_MEMORY_SCOPE_AGENT); }
__device__ __forceinline__ unsigned xb_xcc_id() { return (unsigned)__builtin_amdgcn_s_getreg((3 << 11) | 20) & 0xFu; }
#define XB_SPIN(cond, bar) do { unsigned _sp = 0; while (cond) { __builtin_amdgcn_s_sleep(1); \
    if ((++_sp & 255u) == 0u) { if (xb_ld(&(bar)[XB_TMO])) break; if (_sp > XB_SPIN_CAP) { atomicAdd(&(bar)[XB_TMO], 1u); break; } } } } while (0)

struct XcdBarrier {
    unsigned* bar; unsigned x;
    volatile LAS unsigned* st;
};

__device__ __forceinline__ XcdBarrier xcd_barrier_post(unsigned* bar, volatile LAS unsigned* st) {
    XcdBarrier b; b.bar = bar; b.x = xb_xcc_id(); b.st = st;
    if (threadIdx.x == 0) (void)xb_add(&bar[XB_XCNT(b.x)], 1u);
    return b;
}
__device__ __forceinline__ void xcd_barrier_complete(unsigned* bar, unsigned x, unsigned& nloc, unsigned& nx) {
    const unsigned G = gridDim.x * gridDim.y * gridDim.z;
    unsigned sum, cnt, mine, sp = 0u;
    for (;;) {
        sum = 0u; cnt = 0u; mine = 0u;
#pragma unroll
        for (unsigned j = 0; j < 16; ++j) { const unsigned c = xb_ld(&bar[XB_XCNT(j)]); sum += c; cnt += (c > 0u) ? 1u : 0u; mine = (j == x) ? c : mine; }
        if (sum == G) break;
        __builtin_amdgcn_s_sleep(1);
        if ((++sp & 255u) == 0u) { if (xb_ld(&bar[XB_TMO])) break; if (sp > XB_SPIN_CAP) { atomicAdd(&bar[XB_TMO], 1u); break; } }
    }
    nloc = mine > 0u ? mine : 1u; nx = cnt > 0u ? cnt : 1u;
}

__device__ __forceinline__ void xcd_barrier(const XcdBarrier& b) {
    asm volatile("s_waitcnt vmcnt(0)" ::: "memory");
    __syncthreads();
    if (threadIdx.x == 0) {
        unsigned* bar = b.bar;
        __builtin_amdgcn_s_waitcnt(0);
        unsigned nloc = b.st[0], nx = b.st[1];
        if (nloc == 0u) { xcd_barrier_complete(bar, b.x, nloc, nx); b.st[0] = nloc; b.st[1] = nx; }
        const unsigned old = xb_add(&bar[XB_XSUB(b.x)], 1u);
        const unsigned gen = old / nloc;
        if (old + 1u == (gen + 1u) * nloc) {
            __builtin_amdgcn_fence(__ATOMIC_RELEASE, "agent");
            asm volatile("s_waitcnt vmcnt(0)" ::: "memory");
            const unsigned og = xb_add(&bar[XB_TOP], 1u);
            const unsigned tg = og / nx;
            if (og + 1u == (tg + 1u) * nx) xb_add(&bar[XB_TOPGEN], 1u);
            else XB_SPIN(xb_ld(&bar[XB_TOPGEN]) == tg, bar);
            __builtin_amdgcn_fence(__ATOMIC_ACQUIRE, "agent");
            xb_add(&bar[XB_XGEN(b.x)], 1u);
            asm volatile("s_waitcnt vmcnt(0)" ::: "memory");
        } else {
            XB_SPIN(xb_ld(&bar[XB_XGEN(b.x)]) == gen, bar);
            __builtin_amdgcn_fence(__ATOMIC_ACQUIRE, "agent");
            asm volatile("s_waitcnt vmcnt(0)" ::: "memory");
        }
    }
    __syncthreads();
}
#ifndef NBF
#define NBF 8
#endif
namespace fx {
constexpr int NWAVES = 8, NTHR = 512;
constexpr int SEQ = 4096, DM = 1024, TT = NBF * SEQ;
constexpr int NPROJ = 4096;
constexpr int MOE_TILES = TT * 2 / 256 + 32, MOE_ROWS = MOE_TILES * 256;
constexpr float LOG2E = 1.4426950408889634f;
constexpr float C2A = 0.10206207261596577f * LOG2E;
constexpr float C2B = 0.125f * LOG2E;
constexpr float EPS = 1e-6f;

constexpr size_t MiB = 1u << 20;
constexpr size_t al(size_t x) { return (x + 4095) & ~(size_t)4095; }
constexpr size_t WS_CTL = 0, CTL_ZERO_BYTES = 1 * MiB;
constexpr int CW_BAR = 4096;
constexpr size_t CTL_MOD = 65536;
constexpr size_t CTL_CNT = 524288;
constexpr size_t WS_WIN = 2 * MiB;
constexpr size_t WS_WUQ = 10 * MiB;
constexpr size_t WS_WKV = 10 * MiB + 512 * 1024;
constexpr size_t WS_WOAB = 11 * MiB;
constexpr size_t WS_WOUT = 13 * MiB;
constexpr size_t WS_WGU = 16 * MiB;
constexpr size_t WS_WD = 48 * MiB;
constexpr size_t WS_CS = 64 * MiB;
constexpr size_t WS_RT = WS_CS + al((size_t)TT * 16 * 8);
constexpr size_t RT_ARR = al((size_t)TT * 2 * 4);
constexpr size_t WS_RT_E = WS_RT, WS_RT_RANK = WS_RT + RT_ARR, WS_RT_W = WS_RT + 2 * RT_ARR, WS_RT_POS = WS_RT + 3 * RT_ARR;
constexpr size_t WS_RT_RINV = WS_RT + 4 * RT_ARR;
constexpr size_t WS_WROW = WS_RT + 5 * RT_ARR;
constexpr size_t WS_LIST = al(WS_WROW + (size_t)MOE_ROWS * 4);
constexpr size_t WS_MODP = al(WS_LIST + (size_t)MOE_ROWS * 4);
constexpr size_t WS_SSQ_Q = WS_MODP + 3 * MiB, WS_SSQ_KV = WS_SSQ_Q + (size_t)TT * 16;
constexpr size_t WS_SSQ_X = WS_SSQ_KV + (size_t)TT * 16;
constexpr size_t WS_ACT = al(WS_SSQ_X + (size_t)TT * 64);
constexpr size_t SZ_H = (size_t)TT * 1024 * 2;
constexpr size_t WS_H = WS_ACT;
constexpr size_t WS_QLAT = WS_H + SZ_H;
constexpr size_t WS_KVL = WS_QLAT + SZ_H / 4;
constexpr size_t WS_QB = WS_KVL + SZ_H / 4, WS_KB = WS_QB + SZ_H / 2, WS_VB = WS_KB + SZ_H / 2;
constexpr size_t WS_QA = WS_VB + SZ_H / 2;
constexpr size_t WS_KN = WS_QA + SZ_H * 3 / 4, WS_VA = WS_KN + SZ_H / 2;
constexpr size_t WS_KR = WS_VA + SZ_H / 2;
constexpr size_t WS_OAB = WS_KR + SZ_H / 32;
constexpr size_t WS_MERGED = WS_OAB + SZ_H;
constexpr size_t WS_END1 = WS_MERGED + SZ_H;
constexpr size_t WS_ELIST = WS_QLAT;
constexpr size_t WS_EWT = WS_ELIST + (size_t)32 * TT * 4;
constexpr size_t WS_HID = WS_EWT + (size_t)32 * TT * 4;
constexpr size_t WS_YB = WS_HID + (size_t)MOE_ROWS * 512;
constexpr size_t WS_END2 = WS_YB + (size_t)MOE_ROWS * 2048;
constexpr size_t WS_X1 = (WS_END2 <= WS_OAB) ? WS_OAB : (WS_END1 > WS_END2 ? WS_END1 : WS_END2);
constexpr size_t WS_FAST_END = (WS_X1 == WS_OAB) ? (WS_END1 > WS_END2 ? WS_END1 : WS_END2) : WS_X1 + SZ_H;
static_assert(NBF != 8 || WS_FAST_END <= 512 * MiB, "workspace map exceeds 512 MiB");
static_assert(CTL_CNT + 32 * 256 <= CTL_ZERO_BYTES && (CW_BAR + 3 * 3456) * 4 <= (int)CTL_MOD, "ctl map");

constexpr int LDS_BYTES = 163840;
constexpr int RING_OFF = 0;
constexpr int P7S_OFF = 149504;
constexpr int LCTL_OFF = 159744;
static_assert(P7S_OFF + 8192 <= LCTL_OFF, "lds map");

struct Params {
    const float *x, *c; const int* pos;
    const float *w_ada, *b_ada, *g_mix, *w_in, *g_q, *w_uq, *g_kv, *w_uk, *w_uv, *rel, *w_oa, *w_ob, *w_out, *g_ffn, *w_rg, *b_rg, *w_re, *b_re, *w_gate, *w_up, *w_down, *g_final;
    float* out;
    unsigned char* ws;
    int ph_lo, ph_hi;
    int li, pad;
};
typedef const __attribute__((address_space(4))) Params* KP;
}
namespace fx {
using pg8::Unit; using pg8::bf16_t;
typedef float f32x2_t __attribute__((ext_vector_type(2)));
typedef __bf16 bf16x2_t __attribute__((ext_vector_type(2)));
typedef float f32x16 __attribute__((ext_vector_type(16)));
typedef short v4i16_t __attribute__((ext_vector_type(4)));
typedef unsigned u32x2 __attribute__((ext_vector_type(2)));
typedef unsigned u32x4 __attribute__((ext_vector_type(4)));

__device__ __forceinline__ unsigned cvtpk(float lo, float hi) { f32x2_t v = {lo, hi}; bf16x2_t b = __builtin_convertvector(v, bf16x2_t); return __builtin_bit_cast(unsigned, b); }
__device__ __forceinline__ float bf_lo(unsigned u) { return __builtin_bit_cast(float, u << 16); }
__device__ __forceinline__ float bf_hi(unsigned u) { return __builtin_bit_cast(float, u & 0xffff0000u); }
template <int CTRL, int ROWMASK> __device__ __forceinline__ float dpp_add(float v) {
    const int t = __builtin_amdgcn_update_dpp(0, __builtin_bit_cast(int, v), CTRL, ROWMASK, 0xF, false);
    return v + __builtin_bit_cast(float, t);
}
__device__ __forceinline__ float wave_sum(float v) {
    v = dpp_add<0xB1, 0xF>(v); v = dpp_add<0x4E, 0xF>(v); v = dpp_add<0x141, 0xF>(v); v = dpp_add<0x140, 0xF>(v);
    v = dpp_add<0x142, 0xA>(v); v = dpp_add<0x143, 0xC>(v);
    return __builtin_bit_cast(float, __builtin_amdgcn_readlane(__builtin_bit_cast(int, v), 63));
}
__device__ __forceinline__ float fsigmoid(float v) { return __builtin_amdgcn_rcpf(1.0f + __builtin_amdgcn_exp2f(-v * LOG2E)); }
__device__ __forceinline__ u32x4 pack8(const f32x4& a, const f32x4& b) { u32x4 w; w.x = cvtpk(a[0], a[1]); w.y = cvtpk(a[2], a[3]); w.z = cvtpk(b[0], b[1]); w.w = cvtpk(b[2], b[3]); return w; }

struct Frame {
    LAS unsigned char* lds;
    gu32* ctl;
    int tid, lane, wave, vcu, G;
};

struct EpiProj {
    static constexpr bool PERM = true, AFTER_DRAIN = false, MID = false;
    bf16_t *qlat, *kvl, *qb, *kb, *vb, *ga, *gb; float *ssq_q, *ssq_kv;
    __device__ __forceinline__ void operator()(const f32x4 (&acc)[2][2][4][2], const Unit& u, int wr, int wc, int fr, int fq) const {
        const int pn = u.pn;
        bf16_t* base; int ld, ct, mode = 0;
        float* ssqp = nullptr;
        if (pn == 0) { base = qlat; ld = 256; ct = 0; mode = 3; ssqp = ssq_q; }
        else if (pn == 1) { base = kvl; ld = 256; ct = 0; mode = 4; ssqp = ssq_kv; }
        else if (pn < 4) { base = qb; ld = 512; ct = (pn - 2) * 256; mode = 1; }
        else if (pn < 6) { base = kb; ld = 512; ct = (pn - 4) * 256; }
        else if (pn < 8) { base = vb; ld = 512; ct = (pn - 6) * 256; }
        else if (pn < 12) { base = ga; ld = 1024; ct = (pn - 8) * 256; mode = 2; }
        else { base = gb; ld = 1024; ct = (pn - 12) * 256; mode = 2; }
        const int row0 = u.pm * 256 + wr * 64 + fr, col0 = ct + wc * 32 + 8 * fq;
#pragma unroll
        for (int ai = 0; ai < 2; ++ai)
#pragma unroll
            for (int m = 0; m < 4; ++m) {
                const int row = row0 + ai * 128 + m * 16;
                bf16_t* rowp = base + (size_t)row * ld + col0;
                float ss0 = 0.f, ss1 = 0.f;
#pragma unroll
                for (int bj = 0; bj < 2; ++bj) {
                    f32x4 v0 = acc[ai][bj][m][0], v1 = acc[ai][bj][m][1];
                    if (mode == 1) { v0 = v0 * C2B; v1 = v1 * C2B; }
                    if (mode == 2) {
#pragma unroll
                        for (int e = 0; e < 4; ++e) { v0[e] = fsigmoid(v0[e]); v1[e] = fsigmoid(v1[e]); } }
                    const float s = (v0[0] * v0[0] + v0[1] * v0[1]) + (v0[2] * v0[2] + v0[3] * v0[3]) + (v1[0] * v1[0] + v1[1] * v1[1]) + (v1[2] * v1[2] + v1[3] * v1[3]);
                    if (bj == 0) ss0 = s; else ss1 = s;
                    *(u32x4*)(rowp + bj * 128) = pack8(v0, v1);
                }
                if (mode >= 3) {
                    float s = (mode == 3) ? ss0 + ss1 : ss0;
                    s += __shfl_xor(s, 16); s += __shfl_xor(s, 32);
                    if (fq == 0) ssqp[row * 4 + wc] = s;
                }
            }
    }
};
struct EpiQA {
    static constexpr bool PERM = true, AFTER_DRAIN = false, MID = false;
    bf16_t* qa; const float* ssq_q; const float* cs;
    __device__ __forceinline__ void operator()(const f32x4 (&acc)[2][2][4][2], const Unit& u, int wr, int wc, int fr, int fq) const {
        const int pn = u.pn, row0 = u.pm * 256 + wr * 64 + fr, col0 = pn * 256 + wc * 32 + 8 * fq;
        f32x4 sp[2][4];
#pragma unroll
        for (int ai = 0; ai < 2; ++ai)
#pragma unroll
            for (int m = 0; m < 4; ++m) sp[ai][m] = *(const f32x4*)(ssq_q + (size_t)(row0 + ai * 128 + m * 16) * 4);
#pragma unroll
        for (int ah = 0; ah < 4; ++ah) {
            const int ai = ah >> 1; f32x4 cq[2][4];
            if (pn == 2) {
#pragma unroll
                for (int mm = 0; mm < 2; ++mm) { const f32x4* csr = (const f32x4*)(cs + (size_t)(row0 + ai * 128 + ((ah & 1) * 2 + mm) * 16) * 32 + 16 * (fq & 1));
#pragma unroll
                    for (int j = 0; j < 4; ++j) cq[mm][j] = csr[j]; } }
#pragma unroll
            for (int mm = 0; mm < 2; ++mm) {
                const int m = (ah & 1) * 2 + mm, row = row0 + ai * 128 + m * 16;
                const float sc = C2A / sqrtf(((sp[ai][m][0] + sp[ai][m][1]) + (sp[ai][m][2] + sp[ai][m][3])) * (1.f / 256.f) + EPS);
                bf16_t* rowp = qa + (size_t)row * 768 + col0;
                if (pn < 2) {
#pragma unroll
                    for (int bj = 0; bj < 2; ++bj) *(u32x4*)(rowp + bj * 128) = pack8(acc[ai][bj][m][0] * sc, acc[ai][bj][m][1] * sc);
                } else {
                    const float cc[8] = {cq[mm][0][0], cq[mm][0][2], cq[mm][1][0], cq[mm][1][2], cq[mm][2][0], cq[mm][2][2], cq[mm][3][0], cq[mm][3][2]};
                    const float sn[8] = {cq[mm][0][1], cq[mm][0][3], cq[mm][1][1], cq[mm][1][3], cq[mm][2][1], cq[mm][2][3], cq[mm][3][1], cq[mm][3][3]};
                    const float sgn = (fq < 2) ? -1.f : 1.f;
#pragma unroll
                    for (int bj = 0; bj < 2; ++bj) {
                        f32x4 o[2];
#pragma unroll
                        for (int n = 0; n < 2; ++n)
#pragma unroll
                            for (int e = 0; e < 4; ++e) { const float v = acc[ai][bj][m][n][e] * sc; const float p = __shfl_xor(v, 32); o[n][e] = v * cc[4 * n + e] + sgn * p * sn[4 * n + e]; }
                        *(u32x4*)(rowp + bj * 128) = pack8(o[0], o[1]);
                    }
                }
            }
        }
    }
};
struct EpiKV {
    static constexpr bool PERM = true, AFTER_DRAIN = false, MID = false;
    bf16_t *kn, *va; const float* ssq_kv;
    __device__ __forceinline__ void operator()(const f32x4 (&acc)[2][2][4][2], const Unit& u, int wr, int wc, int fr, int fq) const {
        const int pn = u.pn, row0 = u.pm * 256 + wr * 64 + fr, col0 = (pn & 1) * 256 + wc * 32 + 8 * fq;
        bf16_t* base = pn < 2 ? kn : va;
        f32x4 spv[2][4];
#pragma unroll
        for (int ai = 0; ai < 2; ++ai)
#pragma unroll
            for (int m = 0; m < 4; ++m) spv[ai][m] = *(const f32x4*)(ssq_kv + (size_t)(row0 + ai * 128 + m * 16) * 4);
#pragma unroll
        for (int ai = 0; ai < 2; ++ai)
#pragma unroll
            for (int m = 0; m < 4; ++m) {
                const int row = row0 + ai * 128 + m * 16;
                const f32x4 sp = spv[ai][m]; const float sc = 1.0f / sqrtf(((sp[0] + sp[1]) + (sp[2] + sp[3])) * (1.f / 128.f) + EPS);
                bf16_t* rowp = base + (size_t)row * 512 + col0;
#pragma unroll
                for (int bj = 0; bj < 2; ++bj) *(u32x4*)(rowp + bj * 128) = pack8(acc[ai][bj][m][0] * sc, acc[ai][bj][m][1] * sc);
            }
    }
};
struct EpiMerge {
    static constexpr bool PERM = true, AFTER_DRAIN = false, MID = true;
    bf16_t* merged; const bf16_t *ga, *gb;
    __device__ __forceinline__ bool is_mid(const Unit& u) const { return u.pn < 4; }
    __device__ __forceinline__ void mid(f32x4 (&acc)[2][2][4][2], const Unit& u, int wr, int wc, int fr, int fq) const {
        const int row0 = u.pm * 256 + wr * 64 + fr, col0 = u.pn * 256 + wc * 32 + 8 * fq;
#pragma unroll
        for (int ai = 0; ai < 2; ++ai) {
            u32x4 av[4][2], bv[4][2];
#pragma unroll
            for (int m = 0; m < 4; ++m)
#pragma unroll
                for (int bj = 0; bj < 2; ++bj) { const size_t off = (size_t)(row0 + ai * 128 + m * 16) * 1024 + col0 + bj * 128; av[m][bj] = *(const u32x4*)(ga + off); bv[m][bj] = *(const u32x4*)(gb + off); }
#pragma unroll
            for (int m = 0; m < 4; ++m)
#pragma unroll
                for (int bj = 0; bj < 2; ++bj) {
                    const u32x4 a = av[m][bj], c = bv[m][bj];
                    const float sa[8] = {bf_lo(a.x), bf_hi(a.x), bf_lo(a.y), bf_hi(a.y), bf_lo(a.z), bf_hi(a.z), bf_lo(a.w), bf_hi(a.w)};
                    const float sb[8] = {bf_lo(c.x), bf_hi(c.x), bf_lo(c.y), bf_hi(c.y), bf_lo(c.z), bf_hi(c.z), bf_lo(c.w), bf_hi(c.w)};
#pragma unroll
                    for (int e = 0; e < 4; ++e) { acc[ai][bj][m][0][e] *= sa[e] * __builtin_amdgcn_rcpf(fmaxf(sb[e], 1e-12f)); acc[ai][bj][m][1][e] *= sa[4 + e] * __builtin_amdgcn_rcpf(fmaxf(sb[4 + e], 1e-12f)); }
                }
        }
    }
    __device__ __forceinline__ void operator()(const f32x4 (&acc)[2][2][4][2], const Unit& u, int wr, int wc, int fr, int fq) const {
        const int pn = u.pn & 3, pm = u.pm - TT / 256;
        const int row0 = pm * 256 + wr * 64 + fr, col0 = pn * 256 + wc * 32 + 8 * fq;
#pragma unroll
        for (int ai = 0; ai < 2; ++ai) {
            u32x4 bv[4][2];
#pragma unroll
            for (int m = 0; m < 4; ++m)
#pragma unroll
                for (int bj = 0; bj < 2; ++bj) bv[m][bj] = *(const u32x4*)(gb + (size_t)(row0 + ai * 128 + m * 16) * 1024 + col0 + bj * 128);
#pragma unroll
            for (int m = 0; m < 4; ++m)
#pragma unroll
                for (int bj = 0; bj < 2; ++bj) {
                    const u32x4 c = bv[m][bj];
                    const float sb[8] = {bf_lo(c.x), bf_hi(c.x), bf_lo(c.y), bf_hi(c.y), bf_lo(c.z), bf_hi(c.z), bf_lo(c.w), bf_hi(c.w)};
                    f32x4 v0 = acc[ai][bj][m][0], v1 = acc[ai][bj][m][1];
#pragma unroll
                    for (int e = 0; e < 4; ++e) { v0[e] *= fmaxf(sb[e], 1e-12f); v1[e] *= fmaxf(sb[4 + e], 1e-12f); }
                    *(u32x4*)(merged + (size_t)(row0 + ai * 128 + m * 16) * 1024 + col0 + bj * 128) = pack8(v0, v1);
                }
        }
    }
};
struct EpiResid {
    static constexpr bool PERM = true, AFTER_DRAIN = false, MID = false;
    const float* x; bf16_t* x1; const float* mod; float* ssqx;
    __device__ __forceinline__ void operator()(const f32x4 (&acc)[2][2][4][2], const Unit& u, int wr, int wc, int fr, int fq) const {
        const int row0 = u.pm * 256 + wr * 64 + fr, col0 = u.pn * 256 + wc * 32 + 8 * fq;
        const float* gt = mod + (size_t)(u.pm / 16) * 6144 + 2048;
        f32x4 gv[2][2];
#pragma unroll
        for (int bj = 0; bj < 2; ++bj)
#pragma unroll
            for (int n = 0; n < 2; ++n) gv[bj][n] = *(const f32x4*)(gt + col0 + bj * 128 + n * 4);
#pragma unroll
        for (int ai = 0; ai < 2; ++ai) {
            f32x4 xv[4][2][2];
#pragma unroll
            for (int m = 0; m < 4; ++m) { const size_t off = (size_t)(row0 + ai * 128 + m * 16) * 1024 + col0;
#pragma unroll
                for (int bj = 0; bj < 2; ++bj)
#pragma unroll
                    for (int n = 0; n < 2; ++n) xv[m][bj][n] = *(const f32x4*)(x + off + bj * 128 + n * 4); }
#pragma unroll
            for (int m = 0; m < 4; ++m) { const size_t off = (size_t)(row0 + ai * 128 + m * 16) * 1024 + col0; float s = 0.f;
#pragma unroll
                for (int bj = 0; bj < 2; ++bj) {
                    const u32x4 w = pack8(xv[m][bj][0] + gv[bj][0] * acc[ai][bj][m][0], xv[m][bj][1] + gv[bj][1] * acc[ai][bj][m][1]);
                    *(u32x4*)(x1 + off + bj * 128) = w;
                    const float r0 = bf_lo(w.x), r1 = bf_hi(w.x), r2 = bf_lo(w.y), r3 = bf_hi(w.y), r4 = bf_lo(w.z), r5 = bf_hi(w.z), r6 = bf_lo(w.w), r7 = bf_hi(w.w);
                    s += ((r0 * r0 + r1 * r1) + (r2 * r2 + r3 * r3)) + ((r4 * r4 + r5 * r5) + (r6 * r6 + r7 * r7)); }
                s += __shfl_xor(s, 16); s += __shfl_xor(s, 32);
                if (fq == 0) ssqx[(size_t)(row0 + ai * 128 + m * 16) * 16 + u.pn * 4 + wc] = s; }
        }
    }
};
struct EpiGU {
    static constexpr bool PERM = true, AFTER_DRAIN = false, MID = false;
    bf16_t* hid; const float* ewt; const LAS int* tab; const LAS int* toff;
    __device__ __forceinline__ void operator()(const f32x4 (&acc)[2][2][4][2], const Unit& u, int wr, int wc, int fr, int fq) const {
        const int row0 = u.pm * 256 + wr * 64 + fr, col0 = (u.pn & 1) * 128 + wc * 32 + 8 * fq;
        float wv[2][4];
        const int e_ = __builtin_amdgcn_readfirstlane(tab[1 + u.pm]), base_ = __builtin_amdgcn_readfirstlane(toff[e_]) * 256, cnt_ = __builtin_amdgcn_readfirstlane(toff[40 + e_]);
#pragma unroll
        for (int ai = 0; ai < 2; ++ai)
#pragma unroll
            for (int m = 0; m < 4; ++m) { const int idx = row0 + ai * 128 + m * 16 - base_; wv[ai][m] = idx < cnt_ ? ewt[(size_t)e_ * TT + idx] : 0.f; }
#pragma unroll
        for (int ai = 0; ai < 2; ++ai)
#pragma unroll
            for (int m = 0; m < 4; ++m) {
                const int row = row0 + ai * 128 + m * 16; const float w = wv[ai][m];
                f32x4 o[2];
#pragma unroll
                for (int n = 0; n < 2; ++n)
#pragma unroll
                    for (int e = 0; e < 4; ++e) { const float a = acc[ai][0][m][n][e], uu = acc[ai][1][m][n][e]; o[n][e] = a * fsigmoid(a) * uu * w; }
                *(u32x4*)(hid + (size_t)row * 256 + col0) = pack8(o[0], o[1]);
            }
    }
};
struct EpiDown {
    static constexpr bool PERM = true, AFTER_DRAIN = false, MID = false;
    bf16_t* yb;
    __device__ __forceinline__ void operator()(const f32x4 (&acc)[2][2][4][2], const Unit& u, int wr, int wc, int fr, int fq) const {
        const int row0 = u.pm * 256 + wr * 64 + fr, col0 = (u.pn & 3) * 256 + wc * 32 + 8 * fq;
#pragma unroll
        for (int ai = 0; ai < 2; ++ai)
#pragma unroll
            for (int m = 0; m < 4; ++m) { bf16_t* rowp = yb + (size_t)(row0 + ai * 128 + m * 16) * 1024 + col0;
#pragma unroll
                for (int bj = 0; bj < 2; ++bj) *(u32x4*)(rowp + bj * 128) = pack8(acc[ai][bj][m][0], acc[ai][bj][m][1]); }
    }
};

struct PairOrder {
    static constexpr bool GATHER = false; __device__ __forceinline__ unsigned a_row_off(int) const { return 0u; }
    pg8::StaticOrder so;
    __device__ void init(int G, int c) { so.init(TT, 1024, G, c); }
    __device__ bool next(int i, Unit& u) const { if (!so.next(i >> 1, u)) return false; if (i & 1) { u.pm += TT / 256; u.pn += 4; } return true; }
    __device__ __forceinline__ void a_ready(const Unit&) const {}
    __device__ __forceinline__ void done(const Unit&) const {}
};
template <bool GATHER_> struct MoeOrderT {
    static constexpr bool GATHER = GATHER_; const int* elist; const LAS int* toff;
    __device__ __forceinline__ unsigned a_row_off(int r) const {
        const int e = __builtin_amdgcn_readfirstlane(tab[1 + (r >> 8)]), idx = r - __builtin_amdgcn_readfirstlane(toff[e]) * 256, cnt = __builtin_amdgcn_readfirstlane(toff[40 + e]);
        const int tok = elist[(size_t)e * TT + (idx < TT ? idx : TT - 1)]; return (unsigned)(idx < cnt ? tok : 0) * 2048u; }
    const LAS int* tab; int nct, G, c;
    __device__ bool next(int i, Unit& u) const {
        const int nrt = __builtin_amdgcn_readfirstlane(tab[0]); const long L = (long)i * G + c; if (L >= (long)nrt * nct) return false;
        const int rt = (int)(L / nct), ct = (int)(L % nct); u.pm = rt; u.pn = __builtin_amdgcn_readfirstlane(tab[1 + rt]) * nct + ct; return true;
    }
    __device__ __forceinline__ void a_ready(const Unit&) const {}
    __device__ __forceinline__ void done(const Unit&) const {}
};
typedef MoeOrderT<false> MoeOrder;
}
namespace fx {
typedef short bf16x8 __attribute__((ext_vector_type(8)));
__device__ __forceinline__ void tr_item(const float* W, int ldw, int k0, int n0, bf16_t* WT, int ldt, int drow0, const float* kscale, LAS float* scr, int lane) {
    float tv[32];
#pragma unroll
    for (int i = 0; i < 32; ++i) { const int kk = 2 * i + (lane >> 5); tv[i] = W[(size_t)(k0 + kk) * ldw + n0 + (lane & 31)]; }
#pragma unroll
    for (int i = 0; i < 32; ++i) { const int kk = 2 * i + (lane >> 5); float v = tv[i]; if (kscale) v *= kscale[k0 + kk]; scr[kk * 33 + (lane & 31)] = v; }
    LDS_WAIT(); asm volatile("" ::: "memory");
    const int c = lane & 7;
#pragma unroll
    for (int j = 0; j < 4; ++j) { const int n = (lane >> 3) + 8 * j; const LAS float* s = scr + (8 * c) * 33 + n;
        u32x4 o; o.x = cvtpk(s[0 * 33], s[1 * 33]); o.y = cvtpk(s[2 * 33], s[3 * 33]); o.z = cvtpk(s[4 * 33], s[5 * 33]); o.w = cvtpk(s[6 * 33], s[7 * 33]);
        *(u32x4*)(WT + (size_t)(drow0 + n) * ldt + k0 + 8 * c) = o; }
    LDS_WAIT(); asm volatile("" ::: "memory");
}
constexpr int N_DEFERRED = 2 * 256 + 512 + 32 * 384;
__device__ __forceinline__ void tr_deferred(KP P, int r, LAS float* scr, int lane) {
    unsigned char* ws = P->ws;
    bf16_t* WoabT = (bf16_t*)(ws + WS_WOAB); bf16_t* WoutT = (bf16_t*)(ws + WS_WOUT); bf16_t* WguT = (bf16_t*)(ws + WS_WGU); bf16_t* WdT = (bf16_t*)(ws + WS_WD);
    constexpr int I_OA = 8 * 32, I_OUT = 16 * 32, I_G = 16 * 8, I_D = 4 * 32, I_E = 2 * I_G + I_D;
    if (r < I_OA) { const int kb = r / 32, nb = r % 32; tr_item(P->w_oa, 1024, kb * 64, nb * 32, WoabT, 512, nb * 32, nullptr, scr, lane); return; } r -= I_OA;
    if (r < I_OA) { const int kb = r / 32, nb = r % 32; tr_item(P->w_ob, 1024, kb * 64, nb * 32, WoabT, 512, 1024 + nb * 32, nullptr, scr, lane); return; } r -= I_OA;
    if (r < I_OUT) { const int kb = r / 32, nb = r % 32; tr_item(P->w_out, 1024, kb * 64, nb * 32, WoutT, 1024, nb * 32, nullptr, scr, lane); return; } r -= I_OUT;
    const int e = r / I_E; r -= e * I_E;
    if (r < I_G) { const int kb = r / 8, nb = r % 8, n0 = nb * 32; tr_item(P->w_gate + (size_t)e * 262144, 256, kb * 64, n0, WguT, 1024, e * 512 + (n0 >> 7) * 256 + (n0 & 127), nullptr, scr, lane); return; } r -= I_G;
    if (r < I_G) { const int kb = r / 8, nb = r % 8, n0 = nb * 32; tr_item(P->w_up + (size_t)e * 262144, 256, kb * 64, n0, WguT, 1024, e * 512 + (n0 >> 7) * 256 + 128 + (n0 & 127), nullptr, scr, lane); return; } r -= I_G;
    { const int kb = r / 32, nb = r % 32; tr_item(P->w_down + (size_t)e * 262144, 1024, kb * 64, nb * 32, WdT, 256, e * 1024 + nb * 32, nullptr, scr, lane); }
}
__device__ __forceinline__ void p0_prologue(KP P, Frame& F) {
    unsigned char* ws = P->ws;
    LAS float* scr = (LAS float*)(F.lds + RING_OFF + F.wave * 16384);
    const int gw = F.vcu * NWAVES + F.wave, NGW = F.G * NWAVES, lane = F.lane;
    bf16_t* WinT = (bf16_t*)(ws + WS_WIN); bf16_t* WuqT = (bf16_t*)(ws + WS_WUQ); bf16_t* WkvT = (bf16_t*)(ws + WS_WKV);
    constexpr int I_IN = 16 * 125, I_UQ = 4 * 24, I_UK = 2 * 16;
    constexpr int NITEMS = I_IN + I_UQ + 2 * I_UK;
    for (int it = gw; it < NITEMS; it += NGW) {
        int r = it;
        if (r < I_IN) { const int kb = r / 125, nb = r % 125, n0 = nb * 32; tr_item(P->w_in, 4000, kb * 64, n0, WinT, 1024, n0 < 416 ? n0 : n0 + 96, nullptr, scr, lane); continue; } r -= I_IN;
        if (r < I_UQ) { const int kb = r / 24, nb = r % 24, n0 = nb * 32, h = n0 / 96, j = (n0 % 96) / 32; tr_item(P->w_uq, 768, kb * 64, n0, WuqT, 256, j < 2 ? h * 64 + 32 * j : 512 + 32 * h, P->g_q, scr, lane); continue; } r -= I_UQ;
        if (r < I_UK) { const int kb = r / 16, nb = r % 16; tr_item(P->w_uk, 512, kb * 64, nb * 32, WkvT, 256, nb * 32, P->g_kv, scr, lane); continue; } r -= I_UK;
        { const int kb = r / 16, nb = r % 16; tr_item(P->w_uv, 512, kb * 64, nb * 32, WkvT, 256, 512 + nb * 32, P->g_kv, scr, lane); }
    }
    const int gt = gw * 64 + lane, NGT = NGW * 64; const u32x4 z4 = {0u, 0u, 0u, 0u};
    for (int i = gt; i < 12288; i += NGT) *(u32x4*)(WinT + (size_t)416 * 1024 + (size_t)i * 8) = z4;
    for (int i = gt; i < 16384; i += NGT) *(u32x4*)(WkvT + (size_t)(i >> 4) * 256 + 128 + (i & 15) * 8) = z4;
    float* modp = (float*)(ws + WS_MODP);
    for (int it = gw; it < 96 * 16; it += NGW) {
        const int cg = it % 96, ks = it / 96, n = cg * 64 + lane, k0 = ks * 64;
#pragma unroll
        for (int b = 0; b < 8; ++b) { const float cv = P->c[b * 1024 + k0 + lane]; scr[b * 64 + lane] = cv / (1.f + __expf(-cv)); }
        LDS_WAIT(); asm volatile("" ::: "memory");
        float a[8];
#pragma unroll
        for (int b = 0; b < 8; ++b) a[b] = 0.f;
#pragma unroll 16
        for (int k = 0; k < 64; ++k) { const float w = P->w_ada[(size_t)(k0 + k) * 6144 + n];
#pragma unroll
            for (int b = 0; b < 8; ++b) a[b] += scr[b * 64 + k] * w; }
        const float bias = (ks == 0) ? P->b_ada[n] : 0.f;
#pragma unroll
        for (int b = 0; b < 8; ++b) modp[((size_t)ks * 8 + b) * 6144 + n] = a[b] + bias;
        LDS_WAIT(); asm volatile("" ::: "memory");
    }
    f32x2_t* cs = (f32x2_t*)(ws + WS_CS);
    for (int i = gt; i < TT * 16; i += NGT) { const int t = i >> 4, j = i & 15; const float ang = (float)P->pos[t] * powf(10000.0f, -(float)j * (1.f / 16.f)); f32x2_t v; v.x = cosf(ang); v.y = sinf(ang); cs[i] = v; }
}
__device__ __forceinline__ void p1_norm(KP P, Frame& F) {
    const int lane = F.lane, tid = F.tid, wid = F.wave;
    const float* modp = (const float*)(P->ws + WS_MODP); float* modf = (float*)(P->ws + CTL_MOD); bf16_t* H = (bf16_t*)(P->ws + WS_H);
    LAS float* modl = (LAS float*)(F.lds + RING_OFF);
    const int RPW = (TT + F.G - 1) / F.G, row_lo = F.vcu * RPW, b = row_lo / SEQ, wpb = SEQ / RPW, slice = 6144 / wpb, s0 = (F.vcu % wpb) * slice;
    for (int i = tid; i < 2048; i += NTHR) { float a = 0.f;
#pragma unroll
        for (int ks = 0; ks < 16; ++ks) a += modp[((size_t)ks * 8 + b) * 6144 + i];
        modl[i] = a; }
    for (int i = tid; i < slice; i += NTHR) { float a = 0.f;
#pragma unroll
        for (int ks = 0; ks < 16; ++ks) a += modp[((size_t)ks * 8 + b) * 6144 + s0 + i];
        modf[(size_t)b * 6144 + s0 + i] = a; }
    __syncthreads();
    const int rpwave = RPW / NWAVES;
    for (int it = 0; it < rpwave; it += 2) {
        const int m0 = row_lo + wid * rpwave + it;
        f32x4 v[2][4]; float ss[2];
#pragma unroll
        for (int rr = 0; rr < 2; ++rr) { const f32x4* xr = (const f32x4*)(P->x + (size_t)(m0 + rr) * 1024) + lane;
#pragma unroll
            for (int j = 0; j < 4; ++j) v[rr][j] = xr[64 * j]; }
#pragma unroll
        for (int rr = 0; rr < 2; ++rr) { float s = 0.f;
#pragma unroll
            for (int j = 0; j < 4; ++j) s += (v[rr][j][0] * v[rr][j][0] + v[rr][j][1] * v[rr][j][1]) + (v[rr][j][2] * v[rr][j][2] + v[rr][j][3] * v[rr][j][3]);
            ss[rr] = wave_sum(s); }
#pragma unroll
        for (int rr = 0; rr < 2; ++rr) {
            const float inv = 1.0f / sqrtf(ss[rr] * (1.f / 1024.f) + EPS);
            u32x2* o8 = (u32x2*)(H + (size_t)(m0 + rr) * 1024) + lane;
#pragma unroll
            for (int j = 0; j < 4; ++j) { const int col = 4 * lane + 256 * j;
                const f32x4 g = *(const f32x4*)(P->g_mix + col), s1 = *(const LAS f32x4*)(modl + 1024 + col), h1 = *(const LAS f32x4*)(modl + col);
                f32x4 y;
#pragma unroll
                for (int e = 0; e < 4; ++e) y[e] = v[rr][j][e] * inv * g[e] * (1.f + s1[e]) + h1[e];
                u32x2 w; w.x = cvtpk(y[0], y[1]); w.y = cvtpk(y[2], y[3]); o8[64 * j] = w; }
        }
    }
    __syncthreads();
}
__device__ __forceinline__ void p3_krope(KP P, Frame& F) {
    const int gt = (F.vcu * NWAVES + F.wave) * 64 + F.lane, NGT = F.G * NWAVES * 64;
    const bf16_t* kvl = (const bf16_t*)(P->ws + WS_KVL); bf16_t* kr = (bf16_t*)(P->ws + WS_KR); const f32x2_t* cs = (const f32x2_t*)(P->ws + WS_CS);
    for (int i = gt; i < TT * 16; i += NGT) { const int t = i >> 4, j = i & 15;
        const float x1 = bf_lo((unsigned)kvl[(size_t)t * 256 + 128 + j]), x2 = bf_lo((unsigned)kvl[(size_t)t * 256 + 144 + j]); const f32x2_t c = cs[i];
        kr[(size_t)t * 32 + j] = (bf16_t)(cvtpk(x1 * c.x - x2 * c.y, 0.f) & 0xffffu); kr[(size_t)t * 32 + 16 + j] = (bf16_t)(cvtpk(x2 * c.x + x1 * c.y, 0.f) & 0xffffu); }
}
__device__ __forceinline__ int crow(int r, int hi) { return (r & 3) + 8 * (r >> 2) + 4 * hi; }
__device__ __forceinline__ void att_glds16(const void* gsrc, unsigned lds_dst) { unsigned keep;
    asm volatile("s_mov_b32 %0, m0\n\ts_mov_b32 m0, %2\n\ts_nop 0\n\tglobal_load_lds_dwordx4 %1, off\n\ts_mov_b32 m0, %0" : "=&s"(keep) : "v"(gsrc), "s"(lds_dst) : "memory"); }
__device__ __forceinline__ float att_max3(float a, float b, float c) { return __builtin_fmaxf(__builtin_fmaxf(a, b), c); }
__device__ __forceinline__ float att_fadd(float a, float b) { float r; asm("v_add_f32_e32 %0, %1, %2" : "=v"(r) : "v"(a), "v"(b)); return r; }
__device__ __forceinline__ void att_wait(int n) {
    if (n >= 6) asm volatile("s_waitcnt vmcnt(6)" ::: "memory"); else if (n == 4) asm volatile("s_waitcnt vmcnt(4)" ::: "memory");
    else if (n == 3) asm volatile("s_waitcnt vmcnt(3)" ::: "memory"); else if (n == 2) asm volatile("s_waitcnt vmcnt(2)" ::: "memory"); else asm volatile("s_waitcnt vmcnt(0)" ::: "memory");
}
constexpr int ATT_SIDE_OFF = 86016;
static_assert(ATT_SIDE_OFF + 8 * 8704 <= LCTL_OFF, "attention side-job scratch");
template <bool MLA, int MODE = 0>
__device__ __forceinline__ void attn_unit(Frame& F, const bf16_t* Q1, int ldq1, const bf16_t* Q2, int ldq2, const bf16_t* K1, int ldk1, const bf16_t* K2, int ldk2,
                                          const bf16_t* V, int ldv, bf16_t* O, int ldo, int qb, const float* relh, KP P, int side_item) {
    constexpr int NS = MLA ? 6 : 4, K2OFF = 8192, VOFF = MLA ? 12288 : 8192, SLOT = VOFF + 8192, NSLOT = 4, BT_OFF = NSLOT * SLOT;
    LAS unsigned char* lds = F.lds + RING_OFF;
    LAS float* btab = (LAS float*)(lds + BT_OFF);
    const int tid = F.tid, lane = F.lane, wid = F.wave, r32 = lane & 31, hh = lane >> 5;
    const int q0 = qb * 256 + wid * 32, qc = q0 >> 6;
    const int kt_lo = MLA ? 0 : (4 * qb - 8 < 0 ? 0 : 4 * qb - 8), kt_hi = 4 * qb + 3;
    const int my_lo = MLA ? 0 : (qc - 8 < 0 ? 0 : qc - 8), my_hi = qc;
    const bf16_t* k1src = K1 + (size_t)(8 * wid + (lane >> 3)) * ldk1 + (((lane & 7) ^ ((4 * wid + (lane >> 4)) & 7)) << 3);
    const bf16_t* vsrc = V + (size_t)(16 * (wid & 3) + (lane >> 2)) * ldv + (wid >> 2) * 32 + ((lane & 3) << 3);
    const bf16_t* k2src = MLA ? K2 + (size_t)(16 * (wid & 3) + (lane >> 2)) * ldk2 + (((lane & 3) ^ ((lane >> 4) & 3)) << 3) : nullptr;
    const int npt = (MLA && wid < 4) ? 3 : 2;
    const unsigned lds_u = (unsigned)(unsigned long long)lds;
#define ATT_ISSUE(kt) do { const unsigned sl_ = (unsigned)__builtin_amdgcn_readfirstlane((int)(lds_u + ((kt) & 3) * SLOT + wid * 1024)); \
        att_glds16(k1src + (size_t)(kt) * 64 * ldk1, sl_); \
        att_glds16(vsrc + (size_t)(kt) * 64 * ldv, sl_ + VOFF); \
        if (MLA && wid < 4) att_glds16(k2src + (size_t)(kt) * 64 * ldk2, sl_ + K2OFF); } while (0)
    if (!MLA) { for (int i = tid; i < 640; i += NTHR) btab[i] = relh[i < 512 ? i : 512] * LOG2E; __syncthreads(); }
    ATT_ISSUE(kt_lo); if (kt_lo + 1 <= kt_hi) ATT_ISSUE(kt_lo + 1); if (kt_lo + 2 <= kt_hi) ATT_ISSUE(kt_lo + 2);
    bf16x8 qf[NS];
    { const bf16_t* qrow = Q1 + (size_t)(q0 + r32) * ldq1 + 8 * hh;
#pragma unroll
      for (int s = 0; s < 4; ++s) qf[s] = *(const bf16x8*)(qrow + 16 * s);
      if (MLA) { const bf16_t* qrow2 = Q2 + (size_t)(q0 + r32) * ldq2 + 8 * hh;
#pragma unroll
          for (int s = 4; s < NS; ++s) qf[s] = *(const bf16x8*)(qrow2 + 16 * (s - 4)); } }
    if (side_item >= 0 && side_item < N_DEFERRED) tr_deferred(P, side_item, (LAS float*)(F.lds + ATT_SIDE_OFF + wid * 8704), lane);
#pragma unroll
    for (int s = 0; s < NS; ++s) asm volatile("" : "+v"(qf[s]));
    float mref = 0.f, lrun = 0.f; bool first = true; f32x16 o0, o1, negm;
#pragma unroll
    for (int r = 0; r < 16; ++r) { o0[r] = 0.f; o1[r] = 0.f; negm[r] = 0.f; }
    int koff[NS];
#pragma unroll
    for (int s = 0; s < 4; ++s) koff[s] = r32 * 128 + (((2 * s + hh) ^ ((r32 >> 1) & 7)) << 4);
    if (MLA) {
#pragma unroll
        for (int s = 4; s < NS; ++s) koff[s] = K2OFF + r32 * 64 + (((2 * (s - 4) + hh) ^ ((r32 >> 2) & 3)) << 4); }
    const int vrd = VOFF + (4 * hh + ((lane & 15) >> 2)) * 64 + ((lane >> 4) & 1) * 32 + (lane & 3) * 8;
    { const int nout = (kt_hi - kt_lo < 2 ? kt_hi - kt_lo : 2); att_wait(nout * npt); }
    __builtin_amdgcn_s_barrier(); asm volatile("" ::: "memory");
    if (wid >= 4) __builtin_amdgcn_s_setprio(1);
    for (int kt = kt_lo; kt <= kt_hi; ++kt) {
        if (kt + 3 <= kt_hi) ATT_ISSUE(kt + 3);
        if (kt >= my_lo && kt <= my_hi) {
            const LAS unsigned char* Sb = lds + (kt & 3) * SLOT;
            f32x16 p0, p1;
            bf16x8 ka[NS], kb[NS];
#pragma unroll
            for (int s = 0; s < NS; ++s) { ka[s] = *(const LAS bf16x8*)(Sb + koff[s]); kb[s] = *(const LAS bf16x8*)(Sb + koff[s] + (s < 4 ? 4096 : 2048)); }
            __builtin_amdgcn_sched_barrier(0);
#pragma unroll
            for (int s = 0; s < NS; ++s) {
                if (MODE & 2) { asm volatile("" :: "v"(ka[s]), "v"(kb[s])); } else {
                if (s == 0) { p0 = __builtin_amdgcn_mfma_f32_32x32x16_bf16(ka[0], qf[0], negm, 0, 0, 0); p1 = __builtin_amdgcn_mfma_f32_32x32x16_bf16(kb[0], qf[0], negm, 0, 0, 0); }
                else { p0 = __builtin_amdgcn_mfma_f32_32x32x16_bf16(ka[s], qf[s], p0, 0, 0, 0); p1 = __builtin_amdgcn_mfma_f32_32x32x16_bf16(kb[s], qf[s], p1, 0, 0, 0); } }
            }
            bf16x8 vfr[4][2];
#pragma unroll
            for (int s = 0; s < 4; ++s)
#pragma unroll
                for (int ds = 0; ds < 2; ++ds) {
                    const LAS unsigned char* vb = Sb + vrd + ds * 4096 + s * 1024;
                    const v4i16_t lo = __builtin_amdgcn_ds_read_tr16_b64_v4i16((LAS v4i16_t*)vb);
                    const v4i16_t hi = __builtin_amdgcn_ds_read_tr16_b64_v4i16((LAS v4i16_t*)(vb + 512));
                    vfr[s][ds] = (bf16x8){lo[0], lo[1], lo[2], lo[3], hi[0], hi[1], hi[2], hi[3]}; }
            __builtin_amdgcn_sched_barrier(0);
            if (!MLA) {
                if (qc - kt >= 5) { const float bc = btab[512];
#pragma unroll
                    for (int r = 0; r < 16; ++r) { p0[r] += bc; p1[r] += bc; } }
                else {
                    const LAS float* bp = btab + ((q0 + r32) - kt * 64 + 256 - 4 * hh - 59); asm volatile("" : "+v"(bp));
#pragma unroll
                    for (int r = 0; r < 16; ++r) { p0[r] += bp[59 - ((r & 3) + 8 * (r >> 2))]; p1[r] += bp[27 - ((r & 3) + 8 * (r >> 2))]; } }
            }
            {
                float mx = att_max3(p0[0], p0[1], p1[0]), mb = att_max3(p0[2], p0[3], p1[1]); mx = att_max3(mx, p1[2], p1[3]);
#pragma unroll
                for (int r = 4; r < 16; r += 4) { mx = att_max3(mx, p0[r], p0[r + 1]); mb = att_max3(mb, p0[r + 2], p0[r + 3]); mx = att_max3(mx, p1[r], p1[r + 1]); mb = att_max3(mb, p1[r + 2], p1[r + 3]); }
                mx = __builtin_fmaxf(mx, mb);
                { auto rr = __builtin_amdgcn_permlane32_swap(__builtin_bit_cast(unsigned, mx), __builtin_bit_cast(unsigned, mx), false, false); mx = __builtin_fmaxf(__builtin_bit_cast(float, rr[0]), __builtin_bit_cast(float, rr[1])); }
                if (__builtin_expect(first || __any(mx > 8.0f), 0)) {
                    const float dl = first ? mx : __builtin_fmaxf(mx, 0.f); first = false; mref += dl;
                    const float f = __builtin_amdgcn_exp2f(-dl); lrun *= f;
#pragma unroll
                    for (int r = 0; r < 16; ++r) { p0[r] -= dl; p1[r] -= dl; o0[r] *= f; o1[r] *= f; negm[r] = -mref; }
                    asm volatile("" : "+v"(negm));
                }
                float sa = 0.f, sb = 0.f, sc2 = 0.f, sd = 0.f;
#pragma unroll
                for (int r = 0; r < 16; ++r) { p0[r] = __builtin_amdgcn_exp2f(p0[r]); p1[r] = __builtin_amdgcn_exp2f(p1[r]); }
#pragma unroll
                for (int r = 0; r < 16; r += 2) { sa = att_fadd(sa, p0[r]); sb = att_fadd(sb, p0[r + 1]); sc2 = att_fadd(sc2, p1[r]); sd = att_fadd(sd, p1[r + 1]); }
                lrun += att_fadd(att_fadd(sa, sb), att_fadd(sc2, sd));
            }
            u32x4 pw[4];
            pw[0] = (u32x4){cvtpk(p0[0], p0[1]), cvtpk(p0[2], p0[3]), cvtpk(p0[4], p0[5]), cvtpk(p0[6], p0[7])};
            pw[1] = (u32x4){cvtpk(p0[8], p0[9]), cvtpk(p0[10], p0[11]), cvtpk(p0[12], p0[13]), cvtpk(p0[14], p0[15])};
            pw[2] = (u32x4){cvtpk(p1[0], p1[1]), cvtpk(p1[2], p1[3]), cvtpk(p1[4], p1[5]), cvtpk(p1[6], p1[7])};
            pw[3] = (u32x4){cvtpk(p1[8], p1[9]), cvtpk(p1[10], p1[11]), cvtpk(p1[12], p1[13]), cvtpk(p1[14], p1[15])};
#pragma unroll
            for (int s = 0; s < 4; ++s) {
                const bf16x8 pf = __builtin_bit_cast(bf16x8, pw[s]);
                if (MODE & 2) { asm volatile("" :: "v"(vfr[s][0]), "v"(vfr[s][1]), "v"(pf)); }
                else { o0 = __builtin_amdgcn_mfma_f32_32x32x16_bf16(vfr[s][0], pf, o0, 0, 0, 0); o1 = __builtin_amdgcn_mfma_f32_32x32x16_bf16(vfr[s][1], pf, o1, 0, 0, 0); }
            }
        }
        if (kt < kt_hi) { const int nout = (kt_hi - kt - 1 < 2 ? kt_hi - kt - 1 : 2); att_wait(nout * npt); }
        asm volatile("s_waitcnt lgkmcnt(0)" ::: "memory");
        __builtin_amdgcn_s_barrier(); asm volatile("" ::: "memory");
    }
#undef ATT_ISSUE
    if (wid >= 4) __builtin_amdgcn_s_setprio(0);
    const float ltot = lrun + __shfl_xor(lrun, 32); const float il = 1.0f / ltot;
    bf16_t* orow = O + (size_t)(q0 + r32) * ldo;
#pragma unroll
    for (int g = 0; g < 4; ++g) {
        u32x2 w0, w1; w0.x = cvtpk(o0[4 * g] * il, o0[4 * g + 1] * il); w0.y = cvtpk(o0[4 * g + 2] * il, o0[4 * g + 3] * il);
        w1.x = cvtpk(o1[4 * g] * il, o1[4 * g + 1] * il); w1.y = cvtpk(o1[4 * g + 2] * il, o1[4 * g + 3] * il);
        *(u32x2*)(orow + 8 * g + 4 * hh) = w0; *(u32x2*)(orow + 32 + 8 * g + 4 * hh) = w1;
    }
}
template <int MODE = 0> __device__ __forceinline__ void p4_attention(KP P, Frame& F) {
    unsigned char* ws = P->ws;
    const bf16_t* QA = (const bf16_t*)(ws + WS_QA); const bf16_t* KN = (const bf16_t*)(ws + WS_KN); const bf16_t* VA = (const bf16_t*)(ws + WS_VA); const bf16_t* KR = (const bf16_t*)(ws + WS_KR);
    const bf16_t* QB = (const bf16_t*)(ws + WS_QB); const bf16_t* KB = (const bf16_t*)(ws + WS_KB); const bf16_t* VB = (const bf16_t*)(ws + WS_VB);
    bf16_t* OA = (bf16_t*)(ws + WS_OAB); bf16_t* OB = OA + (size_t)TT * 512;
#ifndef ATT_NOMLA
    int uc = 0;
#define ATT_SIDE() (uc < 8 ? F.vcu * 64 + uc * 8 + F.wave : -1)
    for (int p = F.vcu; p < NBF * 64; p += F.G) {
        const int bh = p >> 3, s = p & 7, b = bh >> 3, h = bh & 7; const size_t rb = (size_t)b * SEQ;
#pragma unroll 1
        for (int k = 0; k < 2; ++k) { const int qb = k ? s : 15 - s;
            attn_unit<true, MODE>(F, QA + rb * 768 + h * 64, 768, QA + rb * 768 + 512 + h * 32, 768, KN + rb * 512 + h * 64, 512, KR + rb * 32, 32, VA + rb * 512 + h * 64, 512, OA + rb * 512 + h * 64, 512, qb, nullptr, P, ATT_SIDE()); ++uc; }
    }
#endif
#ifndef ATT_NOBAND
    for (int u = F.vcu; u < NBF * 128; u += F.G) {
        const int bh = u >> 4, qb = u & 15, b = bh >> 3, h = bh & 7; const size_t rb = (size_t)b * SEQ;
        attn_unit<false, MODE>(F, QB + rb * 512 + h * 64, 512, nullptr, 0, KB + rb * 512 + h * 64, 512, nullptr, 0, VB + rb * 512 + h * 64, 512, OB + rb * 512 + h * 64, 512, qb, P->rel + h * 513, P, ATT_SIDE()); ++uc;
    }
#endif
    for (; uc < 8; ++uc) { const int it = ATT_SIDE(); if (it < N_DEFERRED) tr_deferred(P, it, (LAS float*)(F.lds + ATT_SIDE_OFF + F.wave * 8704), F.lane); }
#undef ATT_SIDE
}
}
namespace fx {
constexpr int P7_STRIDE = 1032;
constexpr int P7_PLANE = 36 * P7_STRIDE * 2;
static_assert(2 * P7_PLANE <= P7S_OFF, "router planes");
template <bool dry> __device__ __forceinline__ void p7_route(KP P, Frame& F) {
    const int tid = F.tid, lane = F.lane, wid = F.wave;
    LAS unsigned short* Whi = (LAS unsigned short*)(F.lds); LAS unsigned short* Wlo = (LAS unsigned short*)(F.lds + P7_PLANE);
    LAS int* lcnt = (LAS int*)(F.lds + P7S_OFF);
    LAS int* lbase = lcnt + 32;
    LAS float* cvec = (LAS float*)(lcnt + 64);
    LAS int* rec = lcnt + 128;
    LAS float* recw = (LAS float*)(F.lds + P7S_OFF + 4096);
    const int RPW = (TT + F.G - 1) / F.G;
    const float* mod = (const float*)(P->ws + CTL_MOD); const bf16_t* X1 = (const bf16_t*)(P->ws + WS_X1);
    const int row_lo = F.vcu * RPW, b = row_lo / SEQ; const float* sh = mod + (size_t)b * 6144 + 3072; const float* sc = sh + 1024;
    if (tid < 32) lcnt[tid] = 0;
    float cp[36];
#pragma unroll
    for (int r = 0; r < 36; ++r) cp[r] = 0.f;
    f32x4 wv[2][9]; float gmk[2], shk[2];
#pragma unroll
    for (int kk = 0; kk < 2; ++kk) { const int k = tid + 512 * kk; gmk[kk] = P->g_ffn[k] * (1.f + sc[k]); shk[kk] = sh[k];
        const f32x4* wr = (const f32x4*)(P->w_re + (size_t)k * 32);
#pragma unroll
        for (int c4 = 0; c4 < 8; ++c4) wv[kk][c4] = wr[c4];
        wv[kk][8] = *(const f32x4*)(P->w_rg + (size_t)k * 4); }
#pragma unroll
    for (int kk = 0; kk < 2; ++kk) { const int k = tid + 512 * kk;
#pragma unroll
        for (int c4 = 0; c4 < 9; ++c4)
#pragma unroll
            for (int e4 = 0; e4 < 4; ++e4) {
                const int e = c4 * 4 + e4, g = e >> 3, i8 = e & 7, rho = (c4 < 8) ? (16 * (i8 >> 2) + 4 * g + (i8 & 3)) : (32 + e4);
                const float w = wv[kk][c4][e4]; cp[rho] += shk[kk] * w;
                const float v = w * gmk[kk]; const unsigned hi = cvtpk(v, 0.f) & 0xffffu; const unsigned lo = cvtpk(v - bf_lo(hi), 0.f) & 0xffffu;
                Whi[rho * P7_STRIDE + k] = (unsigned short)hi; Wlo[rho * P7_STRIDE + k] = (unsigned short)lo; }
    }
    {
        LAS float* cw = (LAS float*)(F.lds + P7S_OFF + 6144);
#pragma unroll
        for (int r = 0; r < 36; ++r) { const float sred = wave_sum(cp[r]); if (lane == 0) cw[wid * 36 + r] = sred; }
        __syncthreads();
        if (tid < 36) { float a = 0.f;
#pragma unroll
            for (int w = 0; w < 8; ++w) a += cw[w * 36 + tid];
            float bias; if (tid < 32) { const int jt = tid >> 4, g = (tid & 15) >> 2, i = tid & 3; bias = P->b_re[8 * g + 4 * jt + i]; } else bias = P->b_rg[tid - 32];
            cvec[tid] = a + bias; }
    }
    __syncthreads();
    const int row = lane & 15, q = lane >> 4;
    const float cg = cvec[32 + q]; float cv[2][4];
#pragma unroll
    for (int jt = 0; jt < 2; ++jt)
#pragma unroll
        for (int i = 0; i < 4; ++i) cv[jt][i] = cvec[16 * jt + 4 * q + i];
    float* rinv = (float*)(P->ws + WS_RT_RINV);
    const int arow2 = 32 + (row >> 2);
    const bool has = wid * 16 < RPW;
    const int m = row_lo + wid * 16 + row;
    const u32x4* xr = (const u32x4*)(X1 + (size_t)(has ? m : row_lo) * 1024 + 8 * q);
    if (has) {
        float inv;
        { const f32x4* sq = (const f32x4*)((const float*)(P->ws + WS_SSQ_X) + (size_t)m * 16); const f32x4 s0 = sq[0], s1 = sq[1], s2 = sq[2], s3 = sq[3];
          const float ssq = (((s0[0] + s0[1]) + (s0[2] + s0[3])) + ((s1[0] + s1[1]) + (s1[2] + s1[3]))) + (((s2[0] + s2[1]) + (s2[2] + s2[3])) + ((s3[0] + s3[1]) + (s3[2] + s3[3])));
          inv = 1.0f / sqrtf(ssq * (1.f / 1024.f) + EPS); }
        if (q == 0) rinv[m] = inv;
        f32x4 acc0 = {0.f, 0.f, 0.f, 0.f}, acc1 = acc0, acc2 = acc0;
        bf16_t* h2r = (bf16_t*)(P->ws + WS_H) + (size_t)m * 1024 + 8 * q; const float* gf = P->g_ffn + 8 * q; const float* scq = sc + 8 * q; const float* shq = sh + 8 * q;
        u32x4 xq[8];
#pragma unroll
        for (int j = 0; j < 8; ++j) xq[j] = xr[j * 4];
#pragma unroll 1
        for (int g = 0; g < 4; ++g) {
            u32x4 xn[8];
            if (g < 3) {
#pragma unroll
                for (int j = 0; j < 8; ++j) xn[j] = xr[(8 * (g + 1) + j) * 4]; }
            __builtin_amdgcn_sched_barrier(0);
#pragma unroll
            for (int kk = 0; kk < 8; ++kk) {
                const int ks = 8 * g + kk; const u32x4 xw = xq[kk];
                const bf16x8 bh = __builtin_bit_cast(bf16x8, xw);
                const int ko = ks * 32 + 8 * q;
                const bf16x8 a0h = *(const LAS bf16x8*)(Whi + row * P7_STRIDE + ko), a0l = *(const LAS bf16x8*)(Wlo + row * P7_STRIDE + ko);
                const bf16x8 a1h = *(const LAS bf16x8*)(Whi + (16 + row) * P7_STRIDE + ko), a1l = *(const LAS bf16x8*)(Wlo + (16 + row) * P7_STRIDE + ko);
                const bf16x8 a2h = *(const LAS bf16x8*)(Whi + arow2 * P7_STRIDE + ko), a2l = *(const LAS bf16x8*)(Wlo + arow2 * P7_STRIDE + ko);
                acc0 = __builtin_amdgcn_mfma_f32_16x16x32_bf16(a0h, bh, acc0, 0, 0, 0); acc0 = __builtin_amdgcn_mfma_f32_16x16x32_bf16(a0l, bh, acc0, 0, 0, 0);
                acc1 = __builtin_amdgcn_mfma_f32_16x16x32_bf16(a1h, bh, acc1, 0, 0, 0); acc1 = __builtin_amdgcn_mfma_f32_16x16x32_bf16(a1l, bh, acc1, 0, 0, 0);
                acc2 = __builtin_amdgcn_mfma_f32_16x16x32_bf16(a2h, bh, acc2, 0, 0, 0); acc2 = __builtin_amdgcn_mfma_f32_16x16x32_bf16(a2l, bh, acc2, 0, 0, 0);
                const f32x4 xa = {bf_lo(xw.x), bf_hi(xw.x), bf_lo(xw.y), bf_hi(xw.y)}, xb = {bf_lo(xw.z), bf_hi(xw.z), bf_lo(xw.w), bf_hi(xw.w)};
                const f32x4 ga = *(const f32x4*)(gf + ks * 32), gb = *(const f32x4*)(gf + ks * 32 + 4), sa = *(const f32x4*)(scq + ks * 32), sb = *(const f32x4*)(scq + ks * 32 + 4);
                const f32x4 ha = *(const f32x4*)(shq + ks * 32), hb = *(const f32x4*)(shq + ks * 32 + 4);
                f32x4 ya, yb;
#pragma unroll
                for (int e = 0; e < 4; ++e) { ya[e] = xa[e] * inv * (ga[e] * (1.f + sa[e])) + ha[e]; yb[e] = xb[e] * inv * (gb[e] * (1.f + sb[e])) + hb[e]; }
                *(u32x4*)(h2r + ks * 32) = pack8(ya, yb);
            }
            if (g < 3) {
#pragma unroll
                for (int j = 0; j < 8; ++j) xq[j] = xn[j]; }
        }
        const float lgq = inv * acc2[0] + cg;
        float gm1 = fmaxf(lgq, __shfl_xor(lgq, 16)); gm1 = fmaxf(gm1, __shfl_xor(gm1, 32));
        float es = __expf(lgq - gm1); es += __shfl_xor(es, 16); es += __shfl_xor(es, 32);
        int cand = (lgq == gm1) ? q : 4; { const int o1 = __shfl_xor(cand, 16); cand = cand < o1 ? cand : o1; const int o2 = __shfl_xor(cand, 32); cand = cand < o2 ? cand : o2; }
        const float gw = 1.f / es;
        float ev[8];
#pragma unroll
        for (int i = 0; i < 4; ++i) { ev[i] = inv * acc0[i] + cv[0][i]; ev[4 + i] = inv * acc1[i] + cv[1][i]; }
        float m1 = -1e30f; int i1 = 0;
#pragma unroll
        for (int j = 0; j < 8; ++j) if (ev[j] > m1) { m1 = ev[j]; i1 = j; }
        float m2 = -1e30f; int i2 = 0;
#pragma unroll
        for (int j = 0; j < 8; ++j) if (j != i1 && ev[j] > m2) { m2 = ev[j]; i2 = j; }
        const float p2 = __expf(m2 - m1), w1 = gw / (1.f + p2), w2 = gw * p2 / (1.f + p2);
        if (q == cand) {
            const int rl = wid * 16 + row, e1 = q * 8 + i1, e2 = q * 8 + i2;
            const int r1 = __hip_atomic_fetch_add(lcnt + e1, 1, __ATOMIC_RELAXED, __HIP_MEMORY_SCOPE_WORKGROUP), r2 = __hip_atomic_fetch_add(lcnt + e2, 1, __ATOMIC_RELAXED, __HIP_MEMORY_SCOPE_WORKGROUP);
            rec[rl * 4 + 0] = e1; rec[rl * 4 + 1] = e2; rec[rl * 4 + 2] = r1; rec[rl * 4 + 3] = r2; recw[rl * 2] = w1; recw[rl * 2 + 1] = w2;
        }
    }
    __syncthreads();
    unsigned* gcnt = (unsigned*)(P->ws + CTL_CNT);
    if (tid < 32) lbase[tid] = dry ? 0 : (int)__hip_atomic_fetch_add(gcnt + 64 * tid, (unsigned)lcnt[tid], __ATOMIC_RELAXED, __HIP_MEMORY_SCOPE_AGENT);
    __syncthreads();
    int* rt_e = (int*)(P->ws + WS_RT_E); int* rt_rank = (int*)(P->ws + WS_RT_RANK); float* rt_w = (float*)(P->ws + WS_RT_W);
    if (!dry && tid < RPW && row_lo + tid < TT) { const int mm = row_lo + tid; const int e1 = rec[tid * 4], e2 = rec[tid * 4 + 1];
        rt_e[mm * 2] = e1; rt_e[mm * 2 + 1] = e2; rt_rank[mm * 2] = lbase[e1] + rec[tid * 4 + 2]; rt_rank[mm * 2 + 1] = lbase[e2] + rec[tid * 4 + 3];
        rt_w[mm * 2] = recw[tid * 2]; rt_w[mm * 2 + 1] = recw[tid * 2 + 1];
        int* elist = (int*)(P->ws + WS_ELIST); float* ewt = (float*)(P->ws + WS_EWT);
        const int x1i = lbase[e1] + rec[tid * 4 + 2], x2i = lbase[e2] + rec[tid * 4 + 3];
        elist[(size_t)e1 * TT + x1i] = mm; ewt[(size_t)e1 * TT + x1i] = recw[tid * 2]; elist[(size_t)e2 * TT + x2i] = mm; ewt[(size_t)e2 * TT + x2i] = recw[tid * 2 + 1]; }
    __syncthreads();
}
__device__ __forceinline__ void moe_tables(KP P, Frame& F, LAS int* tab, LAS int* toff) {
    const unsigned* gcnt = (const unsigned*)(P->ws + CTL_CNT);
    LAS int* cnt_s = toff + 40;
    if (F.tid < 32) cnt_s[F.tid] = (int)__hip_atomic_load(gcnt + 64 * F.tid, __ATOMIC_RELAXED, __HIP_MEMORY_SCOPE_AGENT);
    __syncthreads();
    if (F.tid == 0) {
        int acc = 0;
        for (int e = 0; e < 32; ++e) { const int c = cnt_s[e]; const int nt = (c + 255) >> 8; toff[e] = acc;
            for (int j = 0; j < nt; ++j) tab[1 + acc + j] = e; acc += nt; }
        toff[32] = acc; tab[0] = acc;
    }
    __syncthreads();
}
__device__ __forceinline__ void p11_final(KP P, Frame& F, const LAS int* toff, const bool dry = false) {
    const int gw = F.vcu * NWAVES + F.wave, NGW = F.G * NWAVES, lane = F.lane;
    const float* mod = (const float*)(P->ws + CTL_MOD); const int* rt_e = (const int*)(P->ws + WS_RT_E); const int* rt_rank = (const int*)(P->ws + WS_RT_RANK); const bf16_t* YB = (const bf16_t*)(P->ws + WS_YB);
    for (int m0 = gw * 2; m0 < TT; m0 += NGW * 2) {
        u32x2 xv[2][4]; u32x2 ya[2][4], yc[2][4]; f32x4 gq[2][4];
#pragma unroll
        for (int rr = 0; rr < 2; ++rr) { const int m = m0 + rr; const float* gt = mod + (size_t)(m / SEQ) * 6144 + 5120;
            const int p1 = toff[rt_e[m * 2]] * 256 + rt_rank[m * 2], p2 = toff[rt_e[m * 2 + 1]] * 256 + rt_rank[m * 2 + 1];
            const u32x2* y1 = (const u32x2*)(YB + (size_t)p1 * 1024) + lane; const u32x2* y2 = (const u32x2*)(YB + (size_t)p2 * 1024) + lane;
            const u32x2* xr = (const u32x2*)((const bf16_t*)(P->ws + WS_X1) + (size_t)m * 1024) + lane;
#pragma unroll
            for (int j = 0; j < 4; ++j) { xv[rr][j] = xr[64 * j]; ya[rr][j] = y1[64 * j]; yc[rr][j] = y2[64 * j]; gq[rr][j] = *(const f32x4*)(gt + 4 * lane + 256 * j); } }
#pragma unroll
        for (int rr = 0; rr < 2; ++rr) { const int m = m0 + rr;
            f32x4 v[4]; float s = 0.f;
#pragma unroll
            for (int j = 0; j < 4; ++j) { const u32x2 xb2 = xv[rr][j]; const f32x4 x4 = {bf_lo(xb2.x), bf_hi(xb2.x), bf_lo(xb2.y), bf_hi(xb2.y)}; const u32x2 a = ya[rr][j], c = yc[rr][j]; const f32x4 g = gq[rr][j];
                v[j][0] = x4[0] + g[0] * (bf_lo(a.x) + bf_lo(c.x)); v[j][1] = x4[1] + g[1] * (bf_hi(a.x) + bf_hi(c.x));
                v[j][2] = x4[2] + g[2] * (bf_lo(a.y) + bf_lo(c.y)); v[j][3] = x4[3] + g[3] * (bf_hi(a.y) + bf_hi(c.y));
                s += (v[j][0] * v[j][0] + v[j][1] * v[j][1]) + (v[j][2] * v[j][2] + v[j][3] * v[j][3]); }
            const float inv = 1.0f / sqrtf(wave_sum(s) * (1.f / 1024.f) + EPS);
            f32x4* xw = (f32x4*)(P->out + (size_t)m * 1024) + lane;
#pragma unroll
            for (int j = 0; j < 4; ++j) { const f32x4 g = *(const f32x4*)(P->g_final + 4 * lane + 256 * j); f32x4 o;
#pragma unroll
                for (int e = 0; e < 4; ++e) o[e] = v[j][e] * inv * g[e];
                if (dry) ((f32x4*)(P->ws + WS_H) + (size_t)m * 256 + lane)[64 * j] = o; else xw[64 * j] = o; }
        }
    }
}

constexpr int N_PHASES = 12;
#ifndef ALIGN56
#define ALIGN56 true
#endif
__global__ void __launch_bounds__(NTHR, 2) mega_fwd(Params P_by_value) {
    KP P = (KP)__builtin_amdgcn_kernarg_segment_ptr();
    extern __shared__ __attribute__((aligned(16))) unsigned char lds_raw[];
    Frame F;
    F.lds = (LAS unsigned char*)lds_raw;
    F.tid = threadIdx.x; F.lane = F.tid & 63; F.wave = __builtin_amdgcn_readfirstlane(F.tid >> 6);
    F.G = gridDim.x; { const int bx = blockIdx.x; F.vcu = (F.G % 8 == 0) ? (bx % 8) * (F.G / 8) + bx / 8 : bx; }
    unsigned char* ws = P->ws;
    F.ctl = (gu32*)(ws + WS_CTL);
    volatile LAS unsigned* MISC = (volatile LAS unsigned*)(F.lds + LCTL_OFF);
    LAS int* tab = (LAS int*)(F.lds + LCTL_OFF + 256);
    LAS int* toff = (LAS int*)(F.lds + LCTL_OFF + 256 + 2048);
    for (int u = F.tid; u < (LDS_BYTES - LCTL_OFF) / 4; u += NTHR) ((LAS unsigned*)(F.lds + LCTL_OFF))[u] = 0u;
    __syncthreads();
    XcdBarrier bar = xcd_barrier_post((unsigned*)(F.ctl + CW_BAR) + P->li * XCD_BAR_WORDS, MISC + 8);
    const int lo = P->ph_lo, hi = P->ph_hi;
#ifndef PH_MASK
#define PH_MASK 0xFFF
#endif
#define IN(k) ((((PH_MASK) >> (k)) & 1) && lo <= (k) && (k) < hi)
#define SEAM(k) do { if ((k) != 8 && IN(k) && IN((k) + 1)) xcd_barrier(bar); } while (0)
#define REFRESH() do { int t_ = threadIdx.x; asm volatile("" : "+v"(t_)); F.tid = t_; F.lane = t_ & 63; } while (0)
    LAS unsigned char* ring = F.lds + RING_OFF;
    bf16_t* H = (bf16_t*)(ws + WS_H);
    float* ssq_q = (float*)(ws + WS_SSQ_Q); float* ssq_kv = (float*)(ws + WS_SSQ_KV);
    bf16_t* GA = (bf16_t*)P->out; bf16_t* GB = GA + (size_t)TT * 1024;

#ifndef PH_REPEAT
#define PH_REPEAT 0
#endif
#define PHASE(k, ...) do { if (IN(k)) { REFRESH(); { __VA_ARGS__ } if (((PH_REPEAT) >> (k)) & 1) { xcd_barrier(bar); REFRESH(); { __VA_ARGS__ } } } SEAM(k); } while (0)
    PHASE(0, p0_prologue(P, F););
    PHASE(1, p1_norm(P, F););
    PHASE(2, {
        pg8::Gemm g{H, (const bf16_t*)(ws + WS_WIN), TT, NPROJ, 1024}; pg8::StaticOrder S; S.init(TT, NPROJ, F.G, (int)blockIdx.x);
        EpiProj E{(bf16_t*)(ws + WS_QLAT), (bf16_t*)(ws + WS_KVL), (bf16_t*)(ws + WS_QB), (bf16_t*)(ws + WS_KB), (bf16_t*)(ws + WS_VB), GA, GB, ssq_q, ssq_kv};
        pg8::gemm_phase<EpiProj, pg8::StaticOrder, true, true>(ring, g, S, E); });
    PHASE(3, {
        { pg8::Gemm g{(const bf16_t*)(ws + WS_QLAT), (const bf16_t*)(ws + WS_WUQ), TT, 768, 256}; pg8::StaticOrder S; S.init(TT, 768, F.G, (int)blockIdx.x);
          EpiQA E{(bf16_t*)(ws + WS_QA), ssq_q, (const float*)(ws + WS_CS)};
          pg8::gemm_phase<EpiQA, pg8::StaticOrder, true, true>(ring, g, S, E); }
        { pg8::Gemm g{(const bf16_t*)(ws + WS_KVL), (const bf16_t*)(ws + WS_WKV), TT, 1024, 256}; pg8::StaticOrder S; S.init(TT, 1024, F.G, (int)blockIdx.x);
          EpiKV E{(bf16_t*)(ws + WS_KN), (bf16_t*)(ws + WS_VA), ssq_kv};
          pg8::gemm_phase<EpiKV, pg8::StaticOrder, true, true>(ring, g, S, E); }
        REFRESH();
        p3_krope(P, F); });
#ifdef ATT_PROBE
    if (IN(4)) { REFRESH(); p4_attention<ATT_PROBE>(P, F); xcd_barrier(bar); }
#endif
    PHASE(4, p4_attention<0>(P, F););
    PHASE(5, {
        pg8::Gemm g{(const bf16_t*)(ws + WS_OAB), (const bf16_t*)(ws + WS_WOAB), 2 * TT, 2048, 512}; PairOrder S; S.init(F.G, (int)blockIdx.x);
        EpiMerge E{(bf16_t*)(ws + WS_MERGED), GA, GB};
        pg8::gemm_phase<EpiMerge, PairOrder, ALIGN56, true>(ring, g, S, E); });
    PHASE(6, {
        pg8::Gemm g{(const bf16_t*)(ws + WS_MERGED), (const bf16_t*)(ws + WS_WOUT), TT, 1024, 1024}; pg8::StaticOrder S; S.init(TT, 1024, F.G, (int)blockIdx.x);
        EpiResid E{P->x, (bf16_t*)(ws + WS_X1), (const float*)(ws + CTL_MOD), (float*)(ws + WS_SSQ_X)};
        pg8::gemm_phase<EpiResid, pg8::StaticOrder, ALIGN56, true>(ring, g, S, E); });
    if (IN(7) && ((PH_REPEAT >> 7) & 1)) { REFRESH(); p7_route<true>(P, F); xcd_barrier(bar); }
    if (IN(7)) { REFRESH(); p7_route<false>(P, F); } SEAM(7);
    PHASE(9, {
        moe_tables(P, F, tab, toff);
        pg8::Gemm g{(const bf16_t*)(ws + WS_H), (const bf16_t*)(ws + WS_WGU), MOE_ROWS, 32 * 512, 1024}; MoeOrderT<true> S{(const int*)(ws + WS_ELIST), toff, tab, 2, F.G, F.vcu};
        EpiGU E{(bf16_t*)(ws + WS_HID), (const float*)(ws + WS_EWT), tab, toff};
        pg8::gemm_phase<EpiGU, MoeOrderT<true>, true, true>(ring, g, S, E); });
    PHASE(10, {
        if (!IN(9)) moe_tables(P, F, tab, toff);
        pg8::Gemm g{(const bf16_t*)(ws + WS_HID), (const bf16_t*)(ws + WS_WD), MOE_ROWS, 32 * 1024, 256}; MoeOrder S{nullptr, toff, tab, 4, F.G, F.vcu};
        EpiDown E{(bf16_t*)(ws + WS_YB)};
        pg8::gemm_phase<EpiDown, MoeOrder, true, true>(ring, g, S, E); });
    if (IN(11) && ((PH_REPEAT >> 11) & 1)) { REFRESH(); p11_final(P, F, toff, true); xcd_barrier(bar); }
    if (IN(11)) { REFRESH(); if (!IN(10)) moe_tables(P, F, tab, toff); p11_final(P, F, toff); }
#undef IN
#undef SEAM
}

static void fill_params(Params& p, void* const* d_in, float* out, void* ws) {
    p.x = (const float*)d_in[0]; p.c = (const float*)d_in[1]; p.pos = (const int*)d_in[2]; p.w_ada = (const float*)d_in[3]; p.b_ada = (const float*)d_in[4];
    p.g_mix = (const float*)d_in[5]; p.w_in = (const float*)d_in[6]; p.g_q = (const float*)d_in[7]; p.w_uq = (const float*)d_in[8]; p.g_kv = (const float*)d_in[9];
    p.w_uk = (const float*)d_in[10]; p.w_uv = (const float*)d_in[11]; p.rel = (const float*)d_in[12]; p.w_oa = (const float*)d_in[13]; p.w_ob = (const float*)d_in[14];
    p.w_out = (const float*)d_in[15]; p.g_ffn = (const float*)d_in[16]; p.w_rg = (const float*)d_in[17]; p.b_rg = (const float*)d_in[18]; p.w_re = (const float*)d_in[19];
    p.b_re = (const float*)d_in[20]; p.w_gate = (const float*)d_in[21]; p.w_up = (const float*)d_in[22]; p.w_down = (const float*)d_in[23]; p.g_final = (const float*)d_in[24];
    p.out = out; p.ws = (unsigned char*)ws;
}
static bool launch(void* const* d_in, float* out, void* ws, hipStream_t stream, int mode, int ph_lo = 0, int ph_hi = N_PHASES, int li = 0, bool do_memset = true) {
    static int grid = 0;
    if (grid == 0) {
        int dev = 0, cus = 0;
        if (hipGetDevice(&dev) != hipSuccess || hipDeviceGetAttribute(&cus, hipDeviceAttributeMultiprocessorCount, dev) != hipSuccess) { fprintf(stderr, "kernel_launch: device query failed\n"); grid = -1; return false; }
        if (hipFuncSetAttribute((const void*)mega_fwd, hipFuncAttributeMaxDynamicSharedMemorySize, LDS_BYTES) != hipSuccess) { fprintf(stderr, "kernel_launch: hipFuncSetAttribute failed\n"); grid = -1; return false; }
        int per_cu = 0;
        if (hipOccupancyMaxActiveBlocksPerMultiprocessor(&per_cu, (const void*)mega_fwd, NTHR, LDS_BYTES) != hipSuccess || per_cu < 1) fprintf(stderr, "kernel_launch: note: occupancy query says %d workgroups per CU\n", per_cu);
        (void)hipGetLastError();
        grid = cus;
        if (grid != 256) fprintf(stderr, "kernel_launch: note: %d CUs (built for 256)\n", grid);
    }
    if (grid < 0) return false;
    if (do_memset) (void)hipMemsetAsync((char*)ws + WS_CTL, 0, CTL_ZERO_BYTES, stream);
    Params p{}; fill_params(p, d_in, out, ws); p.li = li;
    if (mode == 0) { p.ph_lo = ph_lo; p.ph_hi = ph_hi; hipLaunchKernelGGL(mega_fwd, dim3(grid), dim3(NTHR), LDS_BYTES, stream, p); }
    else for (int k = ph_lo; k < ph_hi; ++k) { p.ph_lo = k; p.ph_hi = k + 1; hipLaunchKernelGGL(mega_fwd, dim3(grid), dim3(NTHR), LDS_BYTES, stream, p); }
    return true;
}
}
#ifndef DBG
#define DBG 0
#endif
#ifndef LAUNCH_MODE
#define LAUNCH_MODE 0
#endif
extern "C" void kernel_launch(void* const* d_in, const int* in_sizes, int n_in, void* d_out, int out_size, void* d_ws, size_t ws_size, hipStream_t stream) {
#if !DBG
    fx::launch(d_in, (float*)d_out, d_ws, stream, LAUNCH_MODE);
#else
    using namespace fx;
    constexpr size_t WS_OUTF = 152 * MiB, WS_ACC = 168 * MiB, WS_NAIVE = 176 * MiB;
    static_assert(WS_FAST_END <= WS_OUTF, "debug map");
    unsigned char* ws = (unsigned char*)d_ws; float* outf = (float*)(ws + WS_OUTF); float* acc = (float*)(ws + WS_ACC);
    nv::In in; nv::fill_in(in, d_in);
    nv::Scratch sc; sc.carve((float*)(ws + WS_NAIVE));
    (void)hipMemsetAsync(acc, 0, 4096, stream);
    hipLaunchKernelGGL(nv::k_mod, dim3(6144 / 256, 8), dim3(256), 0, stream, in.c, in.w_ada, in.b_ada, sc.mod);
    for (int b = nv::NB - 1; b >= 0; --b) nv::forward_batch(in, sc, b, (float*)d_out, stream);
    const int R = TT;
#define CMPB(s, F, ldf, fs, Rp, ldr, rows, cols, rsig) hipLaunchKernelGGL(dbg::k_cmp<true>, dim3(256), dim3(256), 0, stream, (const void*)(F), ldf, fs, Rp, ldr, rows, cols, rsig, acc, s)
#define CMPF(s, F, ldf, fs, Rp, ldr, rows, cols, rsig) hipLaunchKernelGGL(dbg::k_cmp<false>, dim3(256), dim3(256), 0, stream, (const void*)(F), ldf, fs, Rp, ldr, rows, cols, rsig, acc, s)
    launch(d_in, outf, d_ws, stream, LAUNCH_MODE, 0, 6, 0, true);
    CMPF(1, ws + CTL_MOD, 6144, 1.f, sc.mod, 6144, NBF, 6144, 0);
    CMPB(2, ws + WS_H, 1024, 1.f, sc.h, 1024, R, 1024, 0);
    CMPB(3, ws + WS_QLAT, 256, 1.f, sc.proj + nv::C_QLAT, nv::INW, R, 256, 0);
    CMPB(4, ws + WS_KVL, 256, 1.f, sc.proj + nv::C_KVLAT, nv::INW, R, 160, 0);
    CMPB(5, ws + WS_QB, 512, 1.f / C2B, sc.proj + nv::C_QB, nv::INW, R, 512, 0);
    CMPB(6, ws + WS_KB, 512, 1.f, sc.proj + nv::C_KB, nv::INW, R, 512, 0);
    CMPB(7, ws + WS_VB, 512, 1.f, sc.proj + nv::C_VB, nv::INW, R, 512, 0);
    CMPB(8, (unsigned short*)outf, 1024, 1.f, sc.proj + nv::C_GA, nv::INW, R, 1024, 1);
    CMPB(9, (unsigned short*)outf + (size_t)TT * 1024, 1024, 1.f, sc.proj + nv::C_GB, nv::INW, R, 1024, 1);
    for (int h = 0; h < 8; ++h) { CMPB(10, (unsigned short*)(ws + WS_QA) + h * 64, 768, 1.f / C2A, sc.qa + h * 96, 768, R, 64, 0); CMPB(11, (unsigned short*)(ws + WS_QA) + 512 + h * 32, 768, 1.f / C2A, sc.qa + h * 96 + 64, 768, R, 32, 0); }
    CMPB(12, ws + WS_KN, 512, 1.f, sc.kn, 512, R, 512, 0);
    CMPB(13, ws + WS_VA, 512, 1.f, sc.va, 512, R, 512, 0);
    CMPB(14, ws + WS_KR, 32, 1.f, sc.kr, 32, R, 32, 0);
    CMPB(15, ws + WS_OAB, 512, 1.f, sc.oa, 512, R, 512, 0);
    CMPB(16, (unsigned short*)(ws + WS_OAB) + (size_t)TT * 512, 512, 1.f, sc.ob, 512, R, 512, 0);
    CMPB(17, ws + WS_MERGED, 1024, 1.f, sc.A, 1024, R, 1024, 0);
    launch(d_in, outf, d_ws, stream, LAUNCH_MODE, 6, 7, 1, false);
    CMPB(18, ws + WS_X1, 1024, 1.f, sc.x1, 1024, R, 1024, 0);
    launch(d_in, outf, d_ws, stream, LAUNCH_MODE, 7, N_PHASES, 2, false);
    hipLaunchKernelGGL(dbg::k_cmp_route, dim3((R + 255) / 256), dim3(256), 0, stream, (const int*)(ws + WS_RT_E), (const float*)(ws + WS_RT_W), sc.rt_e, sc.rt_w, R, acc, 20);
    CMPF(21, outf, 1024, 1.f, (const float*)d_out, 1024, R, 1024, 0);
    hipLaunchKernelGGL(dbg::k_scale, dim3(1024), dim3(256), 0, stream, (float*)d_out, (size_t)nv::NB * nv::S * 1024, acc, 22, 0.03f, DBG_FIRST);
#endif
}
```
